# Optimizing an MI355X kernel written in HIP

```python
import math
import jax
import jax.numpy as jnp
from jax import lax
import numpy as np

D_MODEL = 1024
BATCH = 4
SEQ = 8192
DEPTH = 2

CTX_LEN = 256
GRID_W = 64
HEAD_DIM = 64
NA_HEADS = 4
NA_ROWS = 8
NA_COLS = 16
SWA_HEADS = 4
SWA_KV_HEADS = 2
SWA_WINDOW = 128
SWA_BLOCK = 128
GMLP_WIDTH = 256
GMLP_GROUPS = 4
GMLP_CHUNK = 128
S5_WIDTH = 256
S5_GROUP = 16
S5_GROUPS = S5_WIDTH // S5_GROUP
S5_STATE = 64
N_BRANCH = 4
BRANCH_WIDTH = 256
FFN_DIM = 2816
N_EXPERTS = 8
TOP_K = 2
EXPERT_DIM = 3584
N_DENSE = (DEPTH + 1) // 2
N_MOE = DEPTH // 2
ROPE_BASE = 10000.0
EPS = 1e-6
NEG_INF = -1e30
F32 = jnp.float32

COL_SIZES = (NA_HEADS * HEAD_DIM, NA_HEADS * HEAD_DIM, NA_HEADS * HEAD_DIM,
             SWA_HEADS * HEAD_DIM, SWA_KV_HEADS * HEAD_DIM, SWA_KV_HEADS * HEAD_DIM,
             GMLP_WIDTH, GMLP_WIDTH, S5_WIDTH, N_BRANCH * D_MODEL)
COL_SPLITS = tuple(int(v) for v in np.cumsum(COL_SIZES)[:-1])
IN_COLS = int(sum(COL_SIZES))

kernel_name = 'hybrid_gated_mixers_diffusion_block'


def rmsnorm(x, g):
    x32 = x.astype(F32)
    y = x32 * lax.rsqrt(jnp.mean(x32 * x32, axis=-1, keepdims=True) + EPS)
    return (y * g.astype(F32)).astype(x.dtype)


def layernorm(x, g, b):
    x32 = x.astype(F32)
    mu = jnp.mean(x32, axis=-1, keepdims=True)
    xc = x32 - mu
    y = xc * lax.rsqrt(jnp.mean(xc * xc, axis=-1, keepdims=True) + EPS)
    return (y * g.astype(F32) + b.astype(F32)).astype(x.dtype)


def heads(t, n):
    return t.reshape(t.shape[0], t.shape[1], n, HEAD_DIM)


def axial_rope(x, rows, cols):
    nq = HEAD_DIM // 4
    inv = ROPE_BASE ** (-jnp.arange(nq, dtype=F32) / nq)

    def rot(xp, pos):
        ang = pos.astype(F32)[:, None] * inv[None, :]
        cos = jnp.cos(ang)[None, :, None, :]
        sin = jnp.sin(ang)[None, :, None, :]
        x1, x2 = xp[..., :nq], xp[..., nq:]
        return jnp.concatenate([x1 * cos - x2 * sin, x1 * sin + x2 * cos], axis=-1)

    half = HEAD_DIM // 2
    return jnp.concatenate([rot(x[..., :half], rows), rot(x[..., half:], cols)], axis=-1).astype(x.dtype)


def ctx_attn(q, k, v):
    b, l, h, hd = q.shape
    s = jnp.einsum('blhd,bmhd->bhlm', q, k).astype(F32) * (HEAD_DIM ** -0.5)
    p = jax.nn.softmax(s, axis=-1).astype(v.dtype)
    return jnp.einsum('bhlm,bmhd->blhd', p, v).reshape(b, l, h * hd)


def neighbourhood_attn(q, k, v, kc, vc, rpb):
    b, s, h, hd = q.shape
    rows = s // GRID_W
    wr = min(NA_ROWS, rows)
    n_win = wr * NA_COLS
    scale = HEAD_DIM ** -0.5
    qg = q.reshape(b, rows, GRID_W, h, hd)
    kg = k.reshape(b, rows, GRID_W, h, hd)
    vg = v.reshape(b, rows, GRID_W, h, hd)
    col = jnp.arange(GRID_W)
    col_start = jnp.clip(col - NA_COLS // 2, 0, GRID_W - NA_COLS)
    col_idx = col_start[:, None] + jnp.arange(NA_COLS)[None, :]
    bias_c = rpb.astype(F32)[:, :, col_idx - col[:, None] + NA_COLS - 1]

    def row_block(r):
        rs = jnp.clip(r - wr // 2, 0, rows - wr)
        q_r = lax.dynamic_index_in_dim(qg, r, axis=1, keepdims=False)
        k_w = lax.dynamic_slice_in_dim(kg, rs, wr, axis=1)[:, :, col_idx]
        v_w = lax.dynamic_slice_in_dim(vg, rs, wr, axis=1)[:, :, col_idx]
        row_off = rs + jnp.arange(wr) - r + NA_ROWS - 1
        bias = jnp.transpose(bias_c[:, row_off], (0, 2, 1, 3))
        s_w = jnp.einsum('bchd,brckhd->bhcrk', q_r, k_w).astype(F32) * scale + bias[None]
        s_c = jnp.einsum('bchd,blhd->bhcl', q_r, kc).astype(F32) * scale
        p = jax.nn.softmax(jnp.concatenate([s_w.reshape(b, h, GRID_W, n_win), s_c], axis=-1), axis=-1)
        p_w = p[..., :n_win].reshape(b, h, GRID_W, wr, NA_COLS).astype(v.dtype)
        p_c = p[..., n_win:].astype(v.dtype)
        return jnp.einsum('bhcrk,brckhd->bchd', p_w, v_w) + jnp.einsum('bhcl,blhd->bchd', p_c, vc)

    out = lax.map(row_block, jnp.arange(rows))
    return jnp.transpose(out, (1, 0, 2, 3, 4)).reshape(b, s, h * hd)


def window_gqa(q, k, v, kc, vc, sink):
    b, s, hq, hd = q.shape
    hkv = k.shape[2]
    g = hq // hkv
    nb = s // SWA_BLOCK
    scale = HEAD_DIM ** -0.5
    qb = q.reshape(b, nb, SWA_BLOCK, hkv, g, hd)
    pad = ((0, 0), (SWA_BLOCK, SWA_BLOCK), (0, 0), (0, 0))
    kp = jnp.pad(k, pad).reshape(b, nb + 2, SWA_BLOCK, hkv, hd)
    vp = jnp.pad(v, pad).reshape(b, nb + 2, SWA_BLOCK, hkv, hd)
    k_band = jnp.concatenate([kp[:, :-2], kp[:, 1:-1], kp[:, 2:]], axis=2)
    v_band = jnp.concatenate([vp[:, :-2], vp[:, 1:-1], vp[:, 2:]], axis=2)
    n_band = 3 * SWA_BLOCK
    blk = jnp.arange(nb)[:, None, None]
    qpos = blk * SWA_BLOCK + jnp.arange(SWA_BLOCK)[None, :, None]
    kpos = (blk - 1) * SWA_BLOCK + jnp.arange(n_band)[None, None, :]
    mask = (jnp.abs(kpos - qpos) <= SWA_WINDOW) & (kpos >= 0) & (kpos < s)
    s_w = jnp.einsum('bnqhgd,bnkhd->bnhgqk', qb, k_band).astype(F32) * scale
    s_w = jnp.where(mask[None, :, None, None], s_w, NEG_INF)
    s_c = jnp.einsum('bnqhgd,blhd->bnhgql', qb, kc).astype(F32) * scale
    sink_col = jnp.broadcast_to(sink.astype(F32).reshape(hkv, g)[None, None, :, :, None, None],
                                (b, nb, hkv, g, SWA_BLOCK, 1))
    p = jax.nn.softmax(jnp.concatenate([s_w, s_c, sink_col], axis=-1), axis=-1)
    n_ctx = kc.shape[1]
    p_w = p[..., :n_band].astype(v.dtype)
    p_c = p[..., n_band:n_band + n_ctx].astype(v.dtype)
    o = jnp.einsum('bnhgqk,bnkhd->bnqhgd', p_w, v_band) + jnp.einsum('bnhgql,blhd->bnqhgd', p_c, vc)
    return o.reshape(b, s, hq * hd)


def ctx_gqa(qc, kc, vc, sink):
    b, l, hq, hd = qc.shape
    hkv = kc.shape[2]
    g = hq // hkv
    qg = qc.reshape(b, l, hkv, g, hd)
    s = jnp.einsum('blhgd,bmhd->bhglm', qg, kc).astype(F32) * (HEAD_DIM ** -0.5)
    sink_col = jnp.broadcast_to(sink.astype(F32).reshape(hkv, g)[None, :, :, None, None], (b, hkv, g, l, 1))
    p = jax.nn.softmax(jnp.concatenate([s, sink_col], axis=-1), axis=-1)[..., :l].astype(vc.dtype)
    return jnp.einsum('bhglm,bmhd->blhgd', p, vc).reshape(b, l, hq * hd)


def chunk_gmlp(u, v, ln_g, ln_b, ws, bs):
    b, n, _ = u.shape
    u = jax.nn.gelu(u)
    v = layernorm(jax.nn.gelu(v), ln_g, ln_b)
    vg = v.reshape(b, n // GMLP_CHUNK, GMLP_CHUNK, GMLP_GROUPS, GMLP_WIDTH // GMLP_GROUPS)
    sg = jnp.einsum('gij,bnjgc->bnigc', ws, vg) + bs.T[None, None, :, :, None]
    return u * sg.reshape(b, n, GMLP_WIDTH)


def s5_discretize(a_re, a_im, log_dt, b_re, b_im):
    lam_re = jnp.minimum(a_re.astype(F32), -1e-4)
    lam_im = a_im.astype(F32)
    dt = jnp.exp(log_dt.astype(F32))[:, None]
    mag = jnp.exp(lam_re * dt)
    ab_re = mag * jnp.cos(lam_im * dt)
    ab_im = mag * jnp.sin(lam_im * dt)
    den = lam_re * lam_re + lam_im * lam_im
    k_re = ((ab_re - 1.0) * lam_re + ab_im * lam_im) / den
    k_im = (ab_im * lam_re - (ab_re - 1.0) * lam_im) / den
    br, bi = b_re.astype(F32), b_im.astype(F32)
    bb_re = k_re[..., None] * br - k_im[..., None] * bi
    bb_im = k_re[..., None] * bi + k_im[..., None] * br
    return ab_re, ab_im, bb_re, bb_im


def s5_scan(u, ab_re, ab_im, bb_re, bb_im, h0_re, h0_im, reverse):
    bu_re = jnp.einsum('bngc,gpc->bngp', u, bb_re)
    bu_im = jnp.einsum('bngc,gpc->bngp', u, bb_im)
    if h0_re is not None:
        first = -1 if reverse else 0
        bu_re = bu_re.at[:, first].add(ab_re * h0_re - ab_im * h0_im)
        bu_im = bu_im.at[:, first].add(ab_re * h0_im + ab_im * h0_re)
    a_re = jnp.broadcast_to(ab_re, bu_re.shape)
    a_im = jnp.broadcast_to(ab_im, bu_im.shape)

    def combine(e1, e2):
        a1r, a1i, b1r, b1i = e1
        a2r, a2i, b2r, b2i = e2
        return (a2r * a1r - a2i * a1i, a2r * a1i + a2i * a1r,
                a2r * b1r - a2i * b1i + b2r, a2r * b1i + a2i * b1r + b2i)

    _, _, x_re, x_im = lax.associative_scan(combine, (a_re, a_im, bu_re, bu_im), reverse=reverse, axis=1)
    return x_re, x_im


def s5_readout(x_re, x_im, c_re, c_im):
    return (jnp.einsum('bngp,gcp->bngc', x_re, c_re.astype(F32))
            - jnp.einsum('bngp,gcp->bngc', x_im, c_im.astype(F32)))


def s5_glu(y, w, b):
    y = jax.nn.gelu(y)
    return y * jax.nn.sigmoid(y @ w + b)


def s5_mixer(ux, uc, a_re, a_im, log_dt, b_re, b_im, c_re, c_im, d, glu_w, glu_b, ctx_out):
    bsz, s, _ = ux.shape
    l = uc.shape[1]
    ug_x = ux.astype(F32).reshape(bsz, s, S5_GROUPS, S5_GROUP)
    ug_c = uc.astype(F32).reshape(bsz, l, S5_GROUPS, S5_GROUP)
    y_x = d.astype(F32) * ux.astype(F32)
    y_c = d.astype(F32) * uc.astype(F32)
    for direction, rev in enumerate((False, True)):
        ab_re, ab_im, bb_re, bb_im = s5_discretize(a_re[direction], a_im[direction], log_dt[direction],
                                                   b_re[direction], b_im[direction])
        xc_re, xc_im = s5_scan(ug_c, ab_re, ab_im, bb_re, bb_im, None, None, rev)
        end = 0 if rev else -1
        xx_re, xx_im = s5_scan(ug_x, ab_re, ab_im, bb_re, bb_im, xc_re[:, end], xc_im[:, end], rev)
        y_x = y_x + s5_readout(xx_re, xx_im, c_re[direction], c_im[direction]).reshape(bsz, s, S5_WIDTH)
        if ctx_out:
            y_c = y_c + s5_readout(xc_re, xc_im, c_re[direction], c_im[direction]).reshape(bsz, l, S5_WIDTH)
    out_x = s5_glu(y_x.astype(ux.dtype), glu_w, glu_b)
    out_c = s5_glu(y_c.astype(uc.dtype), glu_w, glu_b) if ctx_out else None
    return out_x, out_c


def merge_branches(outs, gates, w_branch, w_out):
    dm = w_out.shape[0]
    m = None
    for i, o in enumerate(outs):
        term = jax.nn.sigmoid(gates[..., i * dm:(i + 1) * dm]) * (o @ w_branch[i])
        m = term if m is None else m + term
    return m @ w_out


def token_mixers(zx, zc, rows_pos, cols_pos, rpb, sink, gln_g, gln_b, gws, gbs,
                 a_re, a_im, log_dt, b_re, b_im, c_re, c_im, d, glu_w, glu_b, w_branch, w_out, ctx_out):
    qa, ka, va, qd, kd, vd, gu, gv, su, gates = jnp.split(zx, COL_SPLITS, axis=-1)
    qa_c, ka_c, va_c, qd_c, kd_c, vd_c, gu_c, gv_c, su_c, gates_c = jnp.split(zc, COL_SPLITS, axis=-1)
    ka_ch, va_ch = heads(ka_c, NA_HEADS), heads(va_c, NA_HEADS)
    kd_ch, vd_ch = heads(kd_c, SWA_KV_HEADS), heads(vd_c, SWA_KV_HEADS)
    o_a = neighbourhood_attn(heads(qa, NA_HEADS), heads(ka, NA_HEADS), heads(va, NA_HEADS), ka_ch, va_ch, rpb)
    o_b = chunk_gmlp(gu, gv, gln_g, gln_b, gws, gbs)
    o_cx, o_cc = s5_mixer(su, su_c, a_re, a_im, log_dt, b_re, b_im, c_re, c_im, d, glu_w, glu_b, ctx_out)
    q_d = axial_rope(heads(qd, SWA_HEADS), rows_pos, cols_pos)
    k_d = axial_rope(heads(kd, SWA_KV_HEADS), rows_pos, cols_pos)
    o_d = window_gqa(q_d, k_d, heads(vd, SWA_KV_HEADS), kd_ch, vd_ch, sink)
    out_x = merge_branches((o_a, o_b, o_cx, o_d), gates, w_branch, w_out)
    out_c = None
    if ctx_out:
        o_a_c = ctx_attn(heads(qa_c, NA_HEADS), ka_ch, va_ch)
        o_b_c = chunk_gmlp(gu_c, gv_c, gln_g, gln_b, gws, gbs)
        o_d_c = ctx_gqa(heads(qd_c, SWA_HEADS), kd_ch, vd_ch, sink)
        out_c = merge_branches((o_a_c, o_b_c, o_cc, o_d_c), gates_c, w_branch, w_out)
    return out_x, out_c


def swiglu(h, w1, w3, w2):
    return (jax.nn.silu(h @ w1) * (h @ w3)) @ w2


def moe_ffn(h, router, w1, w3, w2):
    shp = h.shape
    hf = h.reshape(-1, shp[-1])
    logits = (hf @ router).astype(F32)
    top_v, top_i = lax.top_k(logits, TOP_K)
    wts = jax.nn.softmax(top_v, axis=-1)
    comb = jnp.sum(jax.nn.one_hot(top_i, N_EXPERTS, dtype=F32) * wts[..., None], axis=1).astype(h.dtype)
    y = None
    for e in range(N_EXPERTS):
        term = comb[:, e:e + 1] * swiglu(hf, w1[e], w3[e], w2[e])
        y = term if y is None else y + term
    return y.reshape(shp)


def setup_inputs(seed: int = 0) -> dict:
    key = jax.random.key(seed)
    ks = iter(jax.random.split(key, 48))
    dm = D_MODEL

    def nrm(shape, scale):
        return jax.random.normal(next(ks), shape, F32) * scale

    n_idx = jnp.arange(S5_STATE, dtype=F32)
    return {
        'x': nrm((BATCH, SEQ, dm), 1.0),
        'c': nrm((BATCH, dm), 1.0),
        'ctx': nrm((BATCH, CTX_LEN, dm), 1.0),
        'c_ctx': nrm((dm,), 1.0),
        'w_mod': nrm((DEPTH, dm, 6 * dm), 0.5 * dm ** -0.5),
        'b_mod': nrm((DEPTH, 6 * dm), 0.02),
        'g_pre_mix': 1.0 + nrm((DEPTH, dm), 0.02),
        'g_post_mix': 1.0 + nrm((DEPTH, dm), 0.02),
        'g_pre_ffn': 1.0 + nrm((DEPTH, dm), 0.02),
        'g_post_ffn': 1.0 + nrm((DEPTH, dm), 0.02),
        'w_in': nrm((DEPTH, dm, IN_COLS), dm ** -0.5),
        'na_rpb': nrm((DEPTH, NA_HEADS, 2 * NA_ROWS - 1, 2 * NA_COLS - 1), 0.1),
        'swa_sink': nrm((DEPTH, SWA_HEADS), 0.5),
        'gmlp_ln_g': 1.0 + nrm((DEPTH, GMLP_WIDTH), 0.02),
        'gmlp_ln_b': nrm((DEPTH, GMLP_WIDTH), 0.02),
        'gmlp_ws': nrm((DEPTH, GMLP_GROUPS, GMLP_CHUNK, GMLP_CHUNK), GMLP_CHUNK ** -0.5),
        'gmlp_bs': 1.0 + nrm((DEPTH, GMLP_GROUPS, GMLP_CHUNK), 0.02),
        's5_a_re': -0.5 + nrm((DEPTH, 2, S5_GROUPS, S5_STATE), 0.01),
        's5_a_im': math.pi * n_idx + nrm((DEPTH, 2, S5_GROUPS, S5_STATE), 0.01),
        's5_log_dt': jax.random.uniform(next(ks), (DEPTH, 2, S5_GROUPS), F32, math.log(1e-3), math.log(1e-1)),
        's5_b_re': nrm((DEPTH, 2, S5_GROUPS, S5_STATE, S5_GROUP), (2 * S5_GROUP) ** -0.5),
        's5_b_im': nrm((DEPTH, 2, S5_GROUPS, S5_STATE, S5_GROUP), (2 * S5_GROUP) ** -0.5),
        's5_c_re': nrm((DEPTH, 2, S5_GROUPS, S5_GROUP, S5_STATE), S5_STATE ** -0.5),
        's5_c_im': nrm((DEPTH, 2, S5_GROUPS, S5_GROUP, S5_STATE), S5_STATE ** -0.5),
        's5_d': nrm((DEPTH, S5_WIDTH), 0.5),
        's5_glu_w': nrm((DEPTH, S5_WIDTH, S5_WIDTH), S5_WIDTH ** -0.5),
        's5_glu_b': nrm((DEPTH, S5_WIDTH), 0.02),
        'w_branch': nrm((DEPTH, N_BRANCH, BRANCH_WIDTH, dm), BRANCH_WIDTH ** -0.5),
        'w_out': nrm((DEPTH, dm, dm), dm ** -0.5),
        'ffn_w1': nrm((N_DENSE, dm, FFN_DIM), dm ** -0.5),
        'ffn_w3': nrm((N_DENSE, dm, FFN_DIM), dm ** -0.5),
        'ffn_w2': nrm((N_DENSE, FFN_DIM, dm), FFN_DIM ** -0.5),
        'moe_router': nrm((N_MOE, dm, N_EXPERTS), dm ** -0.5),
        'moe_w1': nrm((N_MOE, N_EXPERTS, dm, EXPERT_DIM), dm ** -0.5),
        'moe_w3': nrm((N_MOE, N_EXPERTS, dm, EXPERT_DIM), dm ** -0.5),
        'moe_w2': nrm((N_MOE, N_EXPERTS, EXPERT_DIM, dm), EXPERT_DIM ** -0.5),
    }


def reference(x, c, ctx, c_ctx, w_mod, b_mod, g_pre_mix, g_post_mix, g_pre_ffn, g_post_ffn, w_in,
              na_rpb, swa_sink, gmlp_ln_g, gmlp_ln_b, gmlp_ws, gmlp_bs,
              s5_a_re, s5_a_im, s5_log_dt, s5_b_re, s5_b_im, s5_c_re, s5_c_im, s5_d, s5_glu_w, s5_glu_b,
              w_branch, w_out, ffn_w1, ffn_w3, ffn_w2, moe_router, moe_w1, moe_w3, moe_w2):
    bsz, s, dm = x.shape
    t = jnp.arange(s)
    rows_pos = t // GRID_W
    cols_pos = t % GRID_W
    h_ctx = ctx
    for i in range(DEPTH):
        ctx_out = i < DEPTH - 1
        mod_x = (jax.nn.silu(c) @ w_mod[i] + b_mod[i]).reshape(bsz, 6, 1, dm)
        mod_c = (jax.nn.silu(c_ctx) @ w_mod[i] + b_mod[i]).reshape(6, dm)
        hx = rmsnorm(x, g_pre_mix[i]) * (1.0 + mod_x[:, 1]) + mod_x[:, 0]
        hc = rmsnorm(h_ctx, g_pre_mix[i]) * (1.0 + mod_c[1]) + mod_c[0]
        mx, mc = token_mixers(hx @ w_in[i], hc @ w_in[i], rows_pos, cols_pos, na_rpb[i], swa_sink[i],
                              gmlp_ln_g[i], gmlp_ln_b[i], gmlp_ws[i], gmlp_bs[i],
                              s5_a_re[i], s5_a_im[i], s5_log_dt[i], s5_b_re[i], s5_b_im[i],
                              s5_c_re[i], s5_c_im[i], s5_d[i], s5_glu_w[i], s5_glu_b[i],
                              w_branch[i], w_out[i], ctx_out)
        x = x + mod_x[:, 2] * rmsnorm(mx, g_post_mix[i])
        if ctx_out:
            h_ctx = h_ctx + mod_c[2] * rmsnorm(mc, g_post_mix[i])
        j = i // 2
        hx = rmsnorm(x, g_pre_ffn[i]) * (1.0 + mod_x[:, 4]) + mod_x[:, 3]
        if i % 2 == 0:
            fx = swiglu(hx, ffn_w1[j], ffn_w3[j], ffn_w2[j])
        else:
            fx = moe_ffn(hx, moe_router[j], moe_w1[j], moe_w3[j], moe_w2[j])
        x = x + mod_x[:, 5] * rmsnorm(fx, g_post_ffn[i])
        if ctx_out:
            hc = rmsnorm(h_ctx, g_pre_ffn[i]) * (1.0 + mod_c[4]) + mod_c[3]
            if i % 2 == 0:
                fc = swiglu(hc, ffn_w1[j], ffn_w3[j], ffn_w2[j])
            else:
                fc = moe_ffn(hc, moe_router[j], moe_w1[j], moe_w3[j], moe_w2[j])
            h_ctx = h_ctx + mod_c[5] * rmsnorm(fc, g_post_ffn[i])
    return x
```

```cpp
#include <hip/hip_runtime.h>
#include <cstdio>
#include <cstdint>
#include <cmath>

#ifndef FP8_FFN_UP
#define FP8_FFN_UP 0
#endif
#ifndef FP8_FFN_DN
#define FP8_FFN_DN 0
#endif
#ifndef FP8_P2
#define FP8_P2 0
#endif
#ifndef MK_MULTI
#define MK_MULTI 0
#endif

#define LAS __attribute__((address_space(3)))
#define GAS __attribute__((address_space(1)))
typedef unsigned short bf16_t;
typedef short bf16x8 __attribute__((ext_vector_type(8)));
typedef short s16x4 __attribute__((ext_vector_type(4)));
typedef float f32x4 __attribute__((ext_vector_type(4)));
typedef float f32x2 __attribute__((ext_vector_type(2)));
typedef unsigned u32x4 __attribute__((ext_vector_type(4)));
typedef unsigned u32x2 __attribute__((ext_vector_type(2)));
typedef GAS unsigned gu32;
typedef int v8i_t __attribute__((ext_vector_type(8)));
typedef short bf16x16 __attribute__((ext_vector_type(16)));

constexpr int DM = 1024, NBATCH = 4, SEQ = 8192, NLAT = NBATCH * SEQ, CTXL = 256, NCTX = NBATCH * CTXL, NROW = NLAT + NCTX;
constexpr int ZC = 1408;
constexpr int ZQA = 0, ZKA = 256, ZQD = 512, ZGU = 768, ZGV = 1024, ZKD = 1280;
constexpr int FFN = 2816, EXD = 3584, NEXP = 8;
constexpr int S5M = 1280;
constexpr int S5CH = 1056;
constexpr int MOE_ROWS = 16384;
constexpr float EPS = 1e-6f;
constexpr float LOG2E = 1.4426950408889634f;
constexpr float SC2 = 0.125f * LOG2E;

enum { I_X = 0, I_C, I_CTX, I_CCTX, I_WMOD, I_BMOD, I_GPREMIX, I_GPOSTMIX, I_GPREFFN, I_GPOSTFFN, I_WIN, I_RPB, I_SINK, I_LNG, I_LNB, I_GWS, I_GBS,
       I_ARE, I_AIM, I_LDT, I_BRE, I_BIM, I_CRE, I_CIM, I_D, I_GLUW, I_GLUB, I_WBR, I_WOUT, I_F1, I_F3, I_F2, I_RT, I_M1, I_M3, I_M2, N_IN };

constexpr size_t MiB = 1u << 20;
constexpr size_t WS_CTL = 0, CTL_ZERO_BYTES = 1 * MiB;
constexpr size_t WS_MOD = 1 * MiB;
constexpr size_t WS_ROPE = WS_MOD + 256 * 1024;
constexpr size_t WS_TOPI = 2 * MiB;
constexpr size_t WS_TOPW = WS_TOPI + 256 * 1024;
constexpr size_t WS_SLOT = WS_TOPW + 256 * 1024;
constexpr size_t WS_WCNT = WS_SLOT + 256 * 1024;
constexpr size_t WS_GRP = WS_WCNT + 16 * 1024;
constexpr size_t WS_ROWTOK = 3 * MiB;
constexpr size_t WS_GLUT = 4 * MiB;
constexpr size_t WS_GWS = WS_GLUT + 256 * 1024;
constexpr size_t WS_WS5 = 5 * MiB;
constexpr size_t WS_TG = 13 * MiB;
constexpr size_t WS_WIN = 37 * MiB;
constexpr size_t WS_WG = 45 * MiB;
constexpr size_t WS_WBR = 61 * MiB;
constexpr size_t WS_WOUT = 77 * MiB;
constexpr size_t WS_W13 = 81 * MiB;
constexpr size_t WS_W2 = 92 * MiB;
constexpr size_t WS_MW13 = 98 * MiB;
constexpr size_t WS_MW2 = 210 * MiB;
constexpr size_t WS_HCTX = 266 * MiB;
constexpr size_t WS_VTL = 270 * MiB;
constexpr size_t WS_VTC = 294 * MiB;
constexpr size_t WS_HX = 295 * MiB;
constexpr size_t WS_Z = 361 * MiB;
constexpr size_t WS_O = 452 * MiB;
constexpr size_t WS_AS5 = 518 * MiB;
constexpr size_t WS_SLOC = 548 * MiB;
constexpr size_t WS_YS5 = 568 * MiB;
constexpr size_t WS_PART = 548 * MiB;
constexpr size_t WS_END = 612 * MiB;
constexpr size_t WS_SCR = WS_AS5;
constexpr size_t WS_MB = WS_Z;
constexpr size_t WS_H = WS_Z;
constexpr size_t WS_MY = WS_Z;
constexpr size_t WS_MH = WS_Z + 32 * MiB;
static_assert(WS_Z + (size_t)NROW * ZC * 2 <= WS_O && WS_O + (size_t)NROW * 1024 * 2 <= WS_AS5 && WS_YS5 + (size_t)NROW * 256 * 2 <= WS_END && WS_AS5 + (size_t)16 * S5M * 768 * 2 <= WS_PART, "ws map");
static_assert(WS_H + (size_t)NROW * FFN * 2 <= WS_PART && WS_MH + (size_t)MOE_ROWS * EXD * 2 <= WS_PART && WS_PART + 256 * 262144 <= WS_END, "ws map 2");
static_assert(WS_SCR + 256 * 131072 <= WS_YS5, "ws map 3");

constexpr int CW_TMO = 0, CW_BAR = 4096, CW_CNT = 16384, CW_CUR = 16384 + 64, CW_TAIL = 16384 + 256;

constexpr int RING_BYTES = 131072, LDS_BYTES = 147456, MISC_OFF = LDS_BYTES - 256, GRPL_OFF = 131072 + 1024 + 8192;

__device__ __forceinline__ unsigned f2bf(float f) { unsigned u = __builtin_bit_cast(unsigned, f); return (u + 0x7fffu + ((u >> 16) & 1u)) >> 16; }
typedef __bf16 bf16x2_t __attribute__((ext_vector_type(2)));
__device__ __forceinline__ unsigned pk2(float lo, float hi) { const f32x2 v = {lo, hi}; return __builtin_bit_cast(unsigned, __builtin_convertvector(v, bf16x2_t)); }
__device__ __forceinline__ float clamp8(float x) { return __builtin_amdgcn_fmed3f(x, -448.0f, 448.0f); }
__device__ __forceinline__ unsigned pk4_fp8(float a, float b, float c, float d) { int w = 0; w = __builtin_amdgcn_cvt_pk_fp8_f32(clamp8(a), clamp8(b), w, false); w = __builtin_amdgcn_cvt_pk_fp8_f32(clamp8(c), clamp8(d), w, true); return (unsigned)w; }
__device__ __forceinline__ float bf2f(unsigned b) { return __builtin_bit_cast(float, b << 16); }
__device__ __forceinline__ float bflo(unsigned w) { return __builtin_bit_cast(float, w << 16); }
__device__ __forceinline__ float bfhi(unsigned w) { return __builtin_bit_cast(float, w & 0xffff0000u); }
#define DPP_F(v, ctrl) __builtin_bit_cast(float, __builtin_amdgcn_update_dpp(0, __builtin_bit_cast(int, (v)), (ctrl), 0xF, 0xF, true))
__device__ __forceinline__ float wave_sum(float v) {
    v += DPP_F(v, 0xB1); v += DPP_F(v, 0x4E); v += DPP_F(v, 0x124); v += DPP_F(v, 0x128);
    v += __shfl_xor(v, 16); v += __shfl_xor(v, 32);
    return v;
}
__device__ __forceinline__ float fast_exp2(float x) { return __builtin_amdgcn_exp2f(x); }
__device__ __forceinline__ float rcp_(float x) { return __builtin_amdgcn_rcpf(x); }
__device__ __forceinline__ float sigmoidf_(float x) { return rcp_(1.0f + __expf(-x)); }
__device__ __forceinline__ float siluf_(float x) { return x * rcp_(1.0f + __expf(-x)); }
__device__ __forceinline__ float geluf_(float x) {
    const float u = 0.7978845608028654f * (x + 0.044715f * x * x * x);
    return x * rcp_(1.0f + __expf(-2.0f * u));
}

#define XB_TMO      128
#define XB_XCNT(j)  (256  + 64 * (j))
#define XB_XSUB(j)  (1280 + 64 * (j))
#define XB_XGEN(j)  (2304 + 64 * (j))
#define XB_TOP      3328
#define XB_TOPGEN   3392
#define XCD_BAR_WORDS 3456
#define XB_SPIN_CAP (1u << 22)
__device__ __forceinline__ unsigned xb_ld(unsigned* p)              { return __hip_atomic_load(p, __ATOMIC_RELAXED, __HIP_MEMORY_SCOPE_AGENT); }
__device__ __forceinline__ unsigned xb_add(unsigned* p, unsigned v) { return __hip_atomic_fetch_add(p, v, __ATOMIC_RELAXED, __HIP_MEMORY_SCOPE_AGENT); }
__device__ __forceinline__ unsigned xb_xcc_id() { return (unsigned)__builtin_amdgcn_s_getreg((3 << 11) | 20) & 0xFu; }
#define XB_SPIN(cond, bar) do { unsigned _sp = 0; while (cond) { __builtin_amdgcn_s_sleep(1); \
    if ((++_sp & 255u) == 0u) { if (xb_ld(&(bar)[XB_TMO])) break; if (_sp > XB_SPIN_CAP) { atomicAdd(&(bar)[XB_TMO], 1u); break; } } } } while (0)
struct XcdBarrier { unsigned* bar; unsigned x; volatile LAS unsigned* st; };
__device__ __forceinline__ XcdBarrier xcd_barrier_post(unsigned* bar, volatile LAS unsigned* st) {
    XcdBarrier b; b.bar = bar; b.x = xb_xcc_id(); b.st = st;
    if (threadIdx.x == 0) (void)xb_add(&bar[XB_XCNT(b.x)], 1u);
    return b;
}
__device__ __forceinline__ void xcd_barrier_complete(unsigned* bar, unsigned x, unsigned& nloc, unsigned& nx) {
    const unsigned G = gridDim.x * gridDim.y * gridDim.z;
    unsigned sum, cnt, mine, sp = 0u;
    for (;;) {
        sum = 0u; cnt = 0u; mine = 0u;
#pragma unroll
        for (unsigned j = 0; j < 16; ++j) { const unsigned c = xb_ld(&bar[XB_XCNT(j)]); sum += c; cnt += (c > 0u) ? 1u : 0u; mine = (j == x) ? c : mine; }
        if (sum == G) break;
        __builtin_amdgcn_s_sleep(1);
        if ((++sp & 255u) == 0u) { if (xb_ld(&bar[XB_TMO])) break; if (sp > XB_SPIN_CAP) { atomicAdd(&bar[XB_TMO], 1u); break; } }
    }
    nloc = mine > 0u ? mine : 1u; nx = cnt > 0u ? cnt : 1u;
}
__device__ __forceinline__ void xcd_barrier(const XcdBarrier& b, int tid) {
    asm volatile("s_waitcnt vmcnt(0)" ::: "memory");
    __syncthreads();
    if (tid == 0) {
        unsigned* bar = b.bar;
        __builtin_amdgcn_s_waitcnt(0);
        unsigned nloc = b.st[0], nx = b.st[1];
        if (nloc == 0u) { xcd_barrier_complete(bar, b.x, nloc, nx); b.st[0] = nloc; b.st[1] = nx; }
        const unsigned old = xb_add(&bar[XB_XSUB(b.x)], 1u);
        const unsigned gen = old / nloc;
        if (old + 1u == (gen + 1u) * nloc) {
            __builtin_amdgcn_fence(__ATOMIC_RELEASE, "agent");
            asm volatile("s_waitcnt vmcnt(0)" ::: "memory");
            const unsigned og = xb_add(&bar[XB_TOP], 1u);
            const unsigned tg = og / nx;
            if (og + 1u == (tg + 1u) * nx) xb_add(&bar[XB_TOPGEN], 1u);
            else XB_SPIN(xb_ld(&bar[XB_TOPGEN]) == tg, bar);
            __builtin_amdgcn_fence(__ATOMIC_ACQUIRE, "agent");
            xb_add(&bar[XB_XGEN(b.x)], 1u);
            asm volatile("s_waitcnt vmcnt(0)" ::: "memory");
        } else {
            XB_SPIN(xb_ld(&bar[XB_XGEN(b.x)]) == gen, bar);
            __builtin_amdgcn_fence(__ATOMIC_ACQUIRE, "agent");
            asm volatile("s_waitcnt vmcnt(0)" ::: "memory");
        }
    }
    __syncthreads();
}

__device__ __forceinline__ void tail_signal(unsigned* ctr, int tid) {
    asm volatile("s_waitcnt vmcnt(0)" ::: "memory");
    __syncthreads();
    if (tid == 0) { __builtin_amdgcn_fence(__ATOMIC_RELEASE, "agent"); asm volatile("s_waitcnt vmcnt(0)" ::: "memory"); (void)xb_add(ctr, 1u); }
}
__device__ __forceinline__ void tail_wait(unsigned* ctr, unsigned n, unsigned* bar, int tid) {
    if (tid == 0) { XB_SPIN(xb_ld(ctr) < n, bar); __builtin_amdgcn_fence(__ATOMIC_ACQUIRE, "agent"); asm volatile("s_waitcnt vmcnt(0)" ::: "memory"); }
    __syncthreads();
}
namespace pg8 {
constexpr int BM = 256, BK = 64, HALF = 128, HTB = HALF * BK * 2, STAGE_BYTES = 8 * HTB, IDX_OFF = STAGE_BYTES + 1024;
__host__ __device__ __forceinline__ int lds_byte(int r, int c) { const int st = (r >> 4) * 2 + (c >> 5), rr = r & 15, cc = c & 31, ob = rr * 64 + cc * 2; return st * 1024 + (ob ^ (((ob >> 9) & 1) << 5)); }
__host__ __device__ __forceinline__ void stage_rc(int b, int& R, int& C) { const int st = b / 1024, sb = b % 1024, swz = sb ^ (((sb >> 9) & 1) << 5); R = (st >> 1) * 16 + swz / 64; C = (st & 1) * 32 + (swz % 64) / 2; }

struct Unit { int pm, pn, kind, tag; int aoff, boff; int nt, part; };
struct Gemm { const bf16_t* A0; const bf16_t* A1; const bf16_t* B0; const bf16_t* B1; int lda, ldb, K; const int* rowtab; float* part; int scaleB, scaleA; int lda1; };

template <class Epi, class Sched, bool GATHER = false, bool HALFB = false, bool FP8 = false, bool MIX = false>
__device__ __forceinline__ void gemm_phase(LAS unsigned char* lds, const Gemm g, const Sched& S, const Epi& E, int tid_in) {
    int tid = tid_in; asm volatile("" : "+v"(tid));
    const int wid = __builtin_amdgcn_readfirstlane(tid >> 6), lane = tid & 63, wr = wid >> 2, wc = wid & 3, fr = lane & 15, fq = lane >> 4;
    unsigned voffA[2], voffB[2], voffA1[2]; int Rg[2]; unsigned Cg2[2];
#pragma unroll
    for (int i = 0; i < 2; ++i) { int R, C; stage_rc(tid * 16 + i * 8192, R, C); voffA[i] = (unsigned)(R * g.lda + C) * 2u; voffB[i] = (unsigned)(R * g.ldb + C) * 2u; voffA1[i] = (unsigned)(R * g.lda1 + C) * 2u; Rg[i] = R; Cg2[i] = (unsigned)C * 2u; }
    unsigned vA[2][2];
#define PG8_GOFF(dst, u) do { _Pragma("unroll") for (int _h = 0; _h < 2; ++_h) _Pragma("unroll") for (int _i = 0; _i < 2; ++_i) \
        dst[_h][_i] = (unsigned)g.rowtab[(u).pm * BM + _h * HALF + Rg[_i]] * (unsigned)(g.lda * 2) + Cg2[_i]; } while (0)
    const size_t kstep = (size_t)(BK * 2);
    const size_t hstepA = (size_t)HALF * g.lda * 2, hstepB = (size_t)HALF * g.ldb * 2, hstepA1 = (size_t)HALF * g.lda1 * 2;
    const unsigned ldsw = (unsigned)wid * 1024u;
    const int aoff = lds_byte(wr * 64 + fr, fq * 8), boff = lds_byte(wc * 32 + fr, fq * 8);
#define PG8_SA(b, h) (((b) * 2 + (h)) * HTB)
#define PG8_SB(b, h) ((4 + (b) * 2 + (h)) * HTB)
#define PG8_STAGE(bufoff, gbase, voff) do { _Pragma("unroll") for (int _i = 0; _i < 2; ++_i) \
        __builtin_amdgcn_global_load_lds((const unsigned*)((const char*)(gbase) + (voff)[_i]), (LAS unsigned*)(lds + (bufoff) + ldsw + _i * 8192), 16, 0, 0); } while (0)
#define PG8_STAGE_A(bufoff, gbase, h, nx) do { if constexpr (GATHER) { PG8_STAGE(bufoff, gbase, vA[h]); } \
        else if constexpr (MIX) { const int _k1 = (nx) ? kn : kc; unsigned _v[2]; _v[0] = _k1 ? voffA1[0] : voffA[0]; _v[1] = _k1 ? voffA1[1] : voffA[1]; PG8_STAGE(bufoff, (gbase) + (h) * (_k1 ? hstepA1 : hstepA), _v); } \
        else { PG8_STAGE(bufoff, (gbase) + (h) * hstepA, voffA); } } while (0)
#define PG8_LDA(dst, b, h) do { _Pragma("unroll") for (int m = 0; m < 4; ++m) { dst[m].lo = *(const LAS bf16x8*)(lds + PG8_SA(b, h) + aoff + m * 2048); dst[m].hi = *(const LAS bf16x8*)(lds + PG8_SA(b, h) + aoff + m * 2048 + 1024); } } while (0)
#define PG8_LDB(dst, b, h) do { _Pragma("unroll") for (int n = 0; n < 2; ++n) { dst[n].lo = *(const LAS bf16x8*)(lds + PG8_SB(b, h) + boff + n * 2048); dst[n].hi = *(const LAS bf16x8*)(lds + PG8_SB(b, h) + boff + n * 2048 + 1024); } } while (0)
#define PG8_CAT(f) __builtin_bit_cast(v8i_t, (f))
#define PG8_MMA(ai, bj, At, Bt) do { __builtin_amdgcn_s_setprio(1); if constexpr (F8) { _Pragma("unroll") for (int m = 0; m < 4; ++m) _Pragma("unroll") for (int n = 0; n < 2; ++n) \
        asm volatile("v_mfma_scale_f32_16x16x128_f8f6f4 %0, %1, %2, %0, %3, %4 op_sel_hi:[0,0,0]" : "+v"(acc[ai][bj][m][n]) : "v"(PG8_CAT(Bt[n])), "v"(PG8_CAT(At[m])), "v"(vscB), "v"(vscA)); } \
    else if constexpr (MIX) { _Pragma("unroll") for (int m = 0; m < 4; ++m) _Pragma("unroll") for (int n = 0; n < 2; ++n) { \
        asm volatile("v_mfma_f32_16x16x32_bf16 %0, %1, %2, %0" : "+v"(acc[ai][bj][m][n]) : "v"(Bt[n].lo), "v"(At[m].lo)); asm volatile("v_mfma_f32_16x16x32_bf16 %0, %1, %2, %0" : "+v"(acc[ai][bj][m][n]) : "v"(Bt[n].hi), "v"(At[m].hi)); } } \
    else { _Pragma("unroll") for (int m = 0; m < 4; ++m) _Pragma("unroll") for (int n = 0; n < 2; ++n) _Pragma("unroll") for (int k = 0; k < 2; ++k) \
        acc[ai][bj][m][n] = __builtin_amdgcn_mfma_f32_16x16x32_bf16(k ? Bt[n].hi : Bt[n].lo, k ? At[m].hi : At[m].lo, acc[ai][bj][m][n], 0, 0, 0); } __builtin_amdgcn_s_setprio(0); } while (0)
#define PG8_WAIT_V(n) asm volatile("s_waitcnt vmcnt(" #n ")" ::: "memory")
#define PG8_WAIT_VK do { if constexpr (HALFB) asm volatile("s_waitcnt vmcnt(6)" ::: "memory"); else asm volatile("s_waitcnt vmcnt(8)" ::: "memory"); } while (0)
#define PG8_STAGE_B1(bufoff, gbase) do { if constexpr (!HALFB) PG8_STAGE(bufoff, gbase, voffB); } while (0)
#define PG8_LDB1(dst, b, h) do { if constexpr (!HALFB) PG8_LDB(dst, b, h); } while (0)
#define PG8_MMA1(ai, bj, At, Bt) do { if constexpr (!HALFB) PG8_MMA(ai, bj, At, Bt); } while (0)
#define PG8_WAIT_L(n) asm volatile("s_waitcnt lgkmcnt(" #n ")" ::: "memory")
#define PG8_BAR __builtin_amdgcn_s_barrier()
#define PG8_SCHED __builtin_amdgcn_sched_barrier(0)
#define PG8_ABASE(u) ((const char*)((u).kind ? g.A1 : g.A0) + ((size_t)(u).aoff + (GATHER ? (size_t)0 : (size_t)(u).pm * BM * ((MIX && (u).kind) ? g.lda1 : g.lda))) * 2)
#define PG8_BBASE(u) ((const char*)((u).kind ? g.B1 : g.B0) + ((size_t)(u).boff + (size_t)(u).pn * (HALFB ? HALF : BM) * g.ldb) * 2)
    int vscA = g.scaleA, vscB = g.scaleB; (void)vscA; (void)vscB;
    Unit cur, nxt; int ui = 0;
    if (!S.next(0, cur)) return;
    f32x4 acc[2][2][4][2];
#pragma unroll
    for (int a = 0; a < 2; ++a)
#pragma unroll
        for (int b = 0; b < 2; ++b)
#pragma unroll
            for (int m = 0; m < 4; ++m)
#pragma unroll
                for (int n = 0; n < 2; ++n) acc[a][b][m][n] = (f32x4){0.f, 0.f, 0.f, 0.f};
    bf16x16 At[4], B0[2], B1[2];
    const char* cA = PG8_ABASE(cur); const char* cB = PG8_BBASE(cur);
    int kc = cur.kind, kn = cur.kind; (void)kc; (void)kn;
    if constexpr (GATHER) { PG8_GOFF(vA, cur); }
    PG8_STAGE(PG8_SB(0, 0), cB, voffB); PG8_STAGE_B1(PG8_SB(0, 1), cB + hstepB); PG8_STAGE_A(PG8_SA(0, 0), cA, 0, false); PG8_STAGE_A(PG8_SA(0, 1), cA, 1, false);
    if (wr == 1) PG8_BAR;
    PG8_WAIT_V(2); PG8_BAR;
    PG8_STAGE(PG8_SB(1, 0), cB + kstep, voffB); PG8_STAGE_A(PG8_SA(1, 0), cA + kstep, 0, false); PG8_STAGE_B1(PG8_SB(1, 1), cB + hstepB + kstep);
    if constexpr (HALFB) PG8_WAIT_V(4); else PG8_WAIT_V(6);
    PG8_BAR;
    for (;;) {
        const bool has_next = S.next(ui + 1, nxt);
        const char* nA = has_next ? PG8_ABASE(nxt) : cA; const char* nB = has_next ? PG8_BBASE(nxt) : cB;
        if constexpr (GATHER) { if (has_next) {
            _Pragma("unroll") for (int _h = 0; _h < 2; ++_h) _Pragma("unroll") for (int _i = 0; _i < 2; ++_i)
                __builtin_amdgcn_global_load_lds((const unsigned*)(g.rowtab + nxt.pm * BM + _h * HALF + Rg[_i]), (LAS unsigned*)(lds + IDX_OFF + ((_h * 2 + _i) * 8 + wid) * 256), 4, 0, 0); } }
        const int nt = cur.nt;
#define PG8_TLOOP \
        _Pragma("unroll 1") for (int t = 0; t < nt; t += 2) { \
            const bool last = (t == nt - 2); \
            kc = cur.kind; kn = (last && has_next) ? nxt.kind : cur.kind; \
            const char* a1 = cA + (size_t)(t + 1) * kstep; \
            const char* a2 = last ? nA : cA + (size_t)(t + 2) * kstep; const char* b2 = last ? nB : cB + (size_t)(t + 2) * kstep; \
            const char* a3 = a2 + kstep; const char* b3 = b2 + kstep; \
 \
            PG8_LDB(B0, 0, 0); PG8_LDB1(B1, 0, 1); PG8_SCHED; PG8_LDA(At, 0, 0); PG8_STAGE_A(PG8_SA(1, 1), a1, 1, false); \
            if constexpr (GATHER) { if (last && has_next) { \
                _Pragma("unroll") for (int _h = 0; _h < 2; ++_h) _Pragma("unroll") for (int _i = 0; _i < 2; ++_i) \
                    vA[_h][_i] = *(const LAS unsigned*)(lds + IDX_OFF + ((_h * 2 + _i) * 8 + wid) * 256 + lane * 4) * (unsigned)(g.lda * 2) + Cg2[_i]; } } \
            PG8_WAIT_VK; PG8_WAIT_L(0); PG8_BAR; PG8_MMA(0, 0, At, B0); PG8_MMA1(0, 1, At, B1); PG8_BAR; PG8_SCHED; \
            PG8_LDA(At, 0, 1); PG8_STAGE(PG8_SB(0, 0), b2, voffB); PG8_STAGE_B1(PG8_SB(0, 1), b2 + hstepB); PG8_STAGE_A(PG8_SA(0, 0), a2, 0, last); \
            PG8_WAIT_VK; PG8_WAIT_L(0); PG8_BAR; PG8_MMA(1, 0, At, B0); PG8_MMA1(1, 1, At, B1); PG8_BAR; PG8_SCHED; \
            PG8_LDB(B0, 1, 0); PG8_LDB1(B1, 1, 1); PG8_SCHED; PG8_LDA(At, 1, 0); PG8_STAGE_A(PG8_SA(0, 1), a2, 1, last); \
            PG8_WAIT_VK; PG8_WAIT_L(0); PG8_BAR; PG8_MMA(0, 0, At, B0); PG8_MMA1(0, 1, At, B1); PG8_BAR; PG8_SCHED; \
            PG8_LDA(At, 1, 1); PG8_STAGE(PG8_SB(1, 0), b3, voffB); PG8_STAGE_B1(PG8_SB(1, 1), b3 + hstepB); PG8_STAGE_A(PG8_SA(1, 0), a3, 0, last); \
            PG8_WAIT_VK; PG8_WAIT_L(0); PG8_BAR; PG8_MMA(1, 0, At, B0); PG8_MMA1(1, 1, At, B1); PG8_BAR; PG8_SCHED; \
        } \

        if constexpr (MIX) { if (cur.kind == 0) { constexpr bool F8 = true; PG8_TLOOP } else { constexpr bool F8 = false; PG8_TLOOP } }
        else { constexpr bool F8 = FP8; PG8_TLOOP }
#undef PG8_TLOOP
        if (wr == 0) PG8_BAR;
        if constexpr (FP8 || MIX) asm volatile("s_nop 15\n\ts_nop 15\n\ts_nop 15\n\ts_nop 15" ::: "memory");
        E(acc, cur, wr, wc, fr, fq);
        if (!has_next) break;
#pragma unroll
        for (int a = 0; a < 2; ++a)
#pragma unroll
            for (int b = 0; b < 2; ++b)
#pragma unroll
                for (int m = 0; m < 4; ++m)
#pragma unroll
                    for (int n = 0; n < 2; ++n) acc[a][b][m][n] = (f32x4){0.f, 0.f, 0.f, 0.f};
        cur = nxt; cA = nA; cB = nB; ++ui;
        if (wr == 1) PG8_BAR;
    }
    PG8_WAIT_V(0);
    PG8_BAR;
#undef PG8_SA
#undef PG8_SB
#undef PG8_STAGE
#undef PG8_STAGE_A
#undef PG8_GOFF
#undef PG8_LDA
#undef PG8_LDB
#undef PG8_MMA
#undef PG8_CAT
#undef PG8_WAIT_V
#undef PG8_WAIT_VK
#undef PG8_STAGE_B1
#undef PG8_LDB1
#undef PG8_MMA1
#undef PG8_WAIT_L
#undef PG8_BAR
#undef PG8_SCHED
#undef PG8_ABASE
#undef PG8_BBASE
}
}
struct Args { const float* in[N_IN]; float* out; unsigned char* ws; int ph_lo, ph_hi; };
typedef const __attribute__((address_space(4))) Args* KArgs;

using pg8::Unit;
typedef f32x4 Acc[2][2][4][2];

__device__ __forceinline__ void blk8(int L, int nM, int nN, int& pm, int& pn) {
    const int per = nM * 8; int cb = L / per; const int nfull = nN >> 3; if (cb > nfull) cb = nfull; const int rem = L - cb * per; const int w = (cb < nfull) ? 8 : (nN - 8 * nfull);
    pm = rem / w; pn = 8 * cb + rem % w;
}
struct Sched2D {
    int nM, nN, G, c; int aoff, boff; int ntk; int rot; int pm0 = 0;
    __device__ __forceinline__ int count() const { return nM * nN; }
    __device__ __forceinline__ void unit(int L, Unit& u) const { u.pm = L / nN; u.pn = L % nN; u.kind = 0; u.tag = 0; u.aoff = aoff; u.boff = boff; u.nt = ntk; u.part = -1; }
    __device__ __forceinline__ bool next(int i, Unit& u) const { const int L = i * G + c; if (L >= nM * nN) return false; unit(L, u); if (rot == 1) u.pn = (u.pn + i) % nN;
        if (rot == 2) blk8(L, nM, nN, u.pm, u.pn); u.pm += pm0; return true; }
};
struct SchedS5 {
    int nN, G, c; int astride, bstride; int ntk;
    __device__ __forceinline__ bool next(int i, Unit& u) const {
        const int L = i * G + c; const int per = 5 * nN; if (L >= 16 * per) return false;
        const int g = L / per, r = L % per; u.pm = r / nN; u.pn = r % nN; u.kind = 0; u.tag = g; u.aoff = g * astride; u.boff = g * bstride; u.nt = ntk; u.part = -1; return true;
    }
};
struct SchedMerge {
    int nM, G, c;
    __device__ __forceinline__ bool next(int i, Unit& u) const {
        const int T = (i >> 3) * G + c; if (T >= nM * 8) return false;
        const int gate = (i >> 1) & 3;
        u.pm = T >> 3; u.pn = T & 7; u.kind = i & 1; u.tag = gate; u.aoff = (i & 1) ? gate * 256 : 0; u.boff = gate * 1024 * 512; u.nt = (i & 1) ? 4 : 8; u.part = -1; return true;
    }
};
struct SchedMoe {
    const LAS int* base; int nN, G, c; int bstride; int ntk;
    __device__ __forceinline__ int count() const { return (base[8] >> 8) * nN; }
    __device__ __forceinline__ void unit(int L, Unit& u) const {
        int t, pn_; blk8(L, base[8] >> 8, nN, t, pn_); const int row = t * 256; int e = 0;
#pragma unroll
        for (int k = 1; k < 8; ++k) e += (row >= base[k]) ? 1 : 0;
        u.pm = t; u.pn = pn_; u.kind = 0; u.tag = e; u.aoff = 0; u.boff = e * bstride; u.nt = ntk; u.part = -1;
    }
    __device__ __forceinline__ bool next(int i, Unit& u) const { const int L = i * G + c; if (L >= count()) return false; unit(L, u); return true; }
};
template <class Base> struct SplitTail {
    Base B; int U, G, c, ntk, full, R, s;
    __device__ __forceinline__ void init(const Base& b, int G_, int c_, int ntk_) { B = b; G = G_; c = c_; ntk = ntk_; U = b.count(); full = (U / G) * G; R = U - full; s = 1;
        if (R > 0) { int smax = G / R; if (smax > ntk / 2) smax = ntk / 2; for (int k = smax; k > 1; --k) if ((ntk / 2) % k == 0) { s = k; break; } } }
    __device__ __forceinline__ bool next(int i, Unit& u) const {
        const int L = i * G + c;
        if (L < full || s == 1) { if (L >= U) return false; B.unit(L, u); return true; }
        if (i != full / G || c >= R * s) return false;
        const int t = c / s, p = c - t * s, kt = ntk / s; B.unit(full + t, u); u.aoff += p * kt * 64; u.boff += p * kt * 64; u.nt = kt; u.part = c; return true;
    }
};
template <class Epi, class Base>
__device__ __forceinline__ void gemm_fixup(const SplitTail<Base>& S, const Epi& E, const float* part, int bx) {
    if (S.s == 1) return;
    int tid = threadIdx.x; asm volatile("" : "+v"(tid));
    const int wid = __builtin_amdgcn_readfirstlane(tid >> 6), lane = tid & 63, wr = wid >> 2, wc = wid & 3, fr = lane & 15, fq = lane >> 4;
    for (int t = bx; t < S.R; t += S.G) {
        Unit u; S.B.unit(S.full + t, u);
        f32x4 acc[2][2][4][2];
#pragma unroll
        for (int a = 0; a < 2; ++a)
#pragma unroll
            for (int b = 0; b < 2; ++b)
#pragma unroll
                for (int m = 0; m < 4; ++m)
#pragma unroll
                    for (int n = 0; n < 2; ++n) acc[a][b][m][n] = (f32x4){0.f, 0.f, 0.f, 0.f};
        for (int p = 0; p < S.s; ++p) {
            const f32x4* pp = (const f32x4*)(part + (size_t)(t * S.s + p) * 65536) + tid;
#pragma unroll
            for (int a = 0; a < 2; ++a)
#pragma unroll
                for (int b = 0; b < 2; ++b)
#pragma unroll
                    for (int m = 0; m < 4; ++m)
#pragma unroll
                        for (int n = 0; n < 2; ++n) { acc[a][b][m][n] += *pp; pp += 512; asm volatile("" : "+v"(pp) :: "memory"); }
        }
        E(acc, u, wr, wc, fr, fq);
    }
}

#define EPI_ROW(u, ai, m) ((u).pm * 256 + (ai) * 128 + wr * 64 + (m) * 16 + fr)
#define EPI_COL(bj, n) ((bj) * 128 + wc * 32 + (n) * 16 + 4 * fq)

struct EpiPlain {
    bf16_t* O; int ldc; int mrows;
    __device__ __forceinline__ void operator()(const Acc& acc, const Unit& u, int wr, int wc, int fr, int fq) const {
#pragma unroll
        for (int ai = 0; ai < 2; ++ai)
#pragma unroll
            for (int m = 0; m < 4; ++m) { const int row = EPI_ROW(u, ai, m); if (row < mrows) { bf16_t* rp = O + (size_t)row * ldc + u.pn * 256 + wc * 32 + 8 * fq;
#pragma unroll
                for (int bj = 0; bj < 2; ++bj) { const f32x4 v0 = acc[ai][bj][m][0], v1 = acc[ai][bj][m][1]; u32x4 w; w.x = pk2(v0[0], v0[1]); w.y = pk2(v0[2], v0[3]); w.z = pk2(v1[0], v1[1]); w.w = pk2(v1[2], v1[3]);
                    *(u32x4*)(rp + bj * 128) = w; } } }
    }
};
struct EpiSwiglu {
    bf16_t* H; int ldh;
    __device__ __forceinline__ void operator()(const Acc& acc, const Unit& u, int wr, int wc, int fr, int fq) const {
#pragma unroll
        for (int ai = 0; ai < 2; ++ai)
#pragma unroll
            for (int m = 0; m < 4; ++m) { bf16_t* rp = H + (size_t)EPI_ROW(u, ai, m) * ldh + u.pn * 128 + wc * 32 + 8 * fq; float o[8];
#pragma unroll
                for (int bj = 0; bj < 2; ++bj) { const f32x4 a = acc[ai][bj][m][0], b = acc[ai][bj][m][1];
                    const f32x4 t = a * (-LOG2E); f32x4 ex; ex[0] = fast_exp2(t[0]); ex[1] = fast_exp2(t[1]); ex[2] = fast_exp2(t[2]); ex[3] = fast_exp2(t[3]);
                    const f32x4 dn = ex + 1.0f; f32x4 rc; rc[0] = rcp_(dn[0]); rc[1] = rcp_(dn[1]); rc[2] = rcp_(dn[2]); rc[3] = rcp_(dn[3]);
                    const f32x4 ov = (a * b) * rc; o[4 * bj] = ov[0]; o[4 * bj + 1] = ov[1]; o[4 * bj + 2] = ov[2]; o[4 * bj + 3] = ov[3]; }
                u32x4 w; w.x = pk2(o[0], o[1]); w.y = pk2(o[2], o[3]); w.z = pk2(o[4], o[5]); w.w = pk2(o[6], o[7]); *(u32x4*)rp = w; asm volatile("" ::: "memory"); }
    }
};
struct EpiSwiglu8 {
    unsigned char* H; int ldh;
    __device__ __forceinline__ void operator()(const Acc& acc, const Unit& u, int wr, int wc, int fr, int fq) const {
#pragma unroll
        for (int ai = 0; ai < 2; ++ai)
#pragma unroll
            for (int m = 0; m < 4; ++m) { unsigned char* rp = H + (size_t)EPI_ROW(u, ai, m) * ldh + u.pn * 128 + wc * 32 + 8 * fq; u32x2 w;
#pragma unroll
                for (int bj = 0; bj < 2; ++bj) { const f32x4 a = acc[ai][bj][m][0], b = acc[ai][bj][m][1];
                    const f32x4 t = a * (-LOG2E); f32x4 ex; ex[0] = fast_exp2(t[0]); ex[1] = fast_exp2(t[1]); ex[2] = fast_exp2(t[2]); ex[3] = fast_exp2(t[3]);
                    const f32x4 dn = ex * 0.125f + 0.125f; f32x4 rc; rc[0] = rcp_(dn[0]); rc[1] = rcp_(dn[1]); rc[2] = rcp_(dn[2]); rc[3] = rcp_(dn[3]);
                    const f32x4 o = (a * b) * rc;
                    const unsigned pk = pk4_fp8(o[0], o[1], o[2], o[3]); if (bj == 0) w.x = pk; else w.y = pk; asm volatile("" : "+v"(w)); }
                *(u32x2*)rp = w; asm volatile("" ::: "memory"); }
    }
};
struct EpiZ {
    bf16_t* Z; bf16_t* VTL; bf16_t* VTC; bf16_t* AS5; const float* ropec; const float* ropes;
    __device__ __forceinline__ void operator()(const Acc& acc, const Unit& u, int wr, int wc, int fr, int fq) const {
        const int pn = u.pn; const bool latent = u.pm < 128;
#pragma unroll
        for (int ai = 0; ai < 2; ++ai)
#pragma unroll
            for (int m = 0; m < 4; ++m) {
                const int row = EPI_ROW(u, ai, m);
                if (pn <= 4 || pn == 5) {
#pragma unroll
                    for (int bj = 0; bj < 2; ++bj) {
                        if (pn == 5 && bj == 1) continue;
                        f32x4 v0 = acc[ai][bj][m][0], v1 = acc[ai][bj][m][1];
                        if ((pn == 2 || pn == 5) && latent) {
                            const int t = row & (SEQ - 1); const int pos = (wc & 1) ? (t & 63) : (t >> 6);
                            const f32x4 cs = *(const f32x4*)(ropec + pos * 16 + 4 * fq), sn = *(const f32x4*)(ropes + pos * 16 + 4 * fq);
                            const f32x4 r0 = v0 * cs - v1 * sn, r1 = v0 * sn + v1 * cs; v0 = r0; v1 = r1;
                        }
                        bf16_t* rp = Z + (size_t)row * ZC + (pn < 5 ? pn * 256 : ZKD) + bj * 128 + wc * 32 + 4 * fq;
                        u32x2 w; w.x = pk2(v0[0], v0[1]); w.y = pk2(v0[2], v0[3]); *(u32x2*)(rp) = w;
                        w.x = pk2(v1[0], v1[1]); w.y = pk2(v1[2], v1[3]); *(u32x2*)(rp + 16) = w;
                    }
                }
                if (pn == 5 || pn == 6) {
#pragma unroll
                    for (int bj = 0; bj < 2; ++bj) {
                        if (pn == 5 && bj == 0) continue;
#pragma unroll
                        for (int n = 0; n < 2; ++n) {
                            const int tc = bj * 128 + wc * 32 + n * 16 + 4 * fq;
                            const int hv = (pn == 6) ? (tc >> 6) : 4 + ((tc - 128) >> 6); const int d0 = tc & 63;
                            const f32x4 v = acc[ai][bj][m][n];
                            if (latent) { const int b = row >> 13, t = row & (SEQ - 1); bf16_t* p = VTL + ((size_t)((b * 6 + hv) * 64 + d0)) * SEQ + t;
#pragma unroll
                                for (int e = 0; e < 4; ++e) p[(size_t)e * SEQ] = (bf16_t)f2bf(v[e]); }
                            else { const int rc = row - NLAT, b = rc >> 8, l = rc & 255; bf16_t* p = VTC + ((size_t)((b * 6 + hv) * 64 + d0)) * CTXL + l;
#pragma unroll
                                for (int e = 0; e < 4; ++e) p[(size_t)e * CTXL] = (bf16_t)f2bf(v[e]); }
                        }
                    }
                }
                if (pn == 7) {
                    const int cr = row >> 5, i = row & 31;
#pragma unroll
                    for (int bj = 0; bj < 2; ++bj)
#pragma unroll
                        for (int n = 0; n < 2; ++n) { const int g = bj * 8 + wc * 2 + n; const f32x4 v = acc[ai][bj][m][n];
                            u32x2 w; w.x = pk2(v[0], v[1]); w.y = pk2(v[2], v[3]); *(u32x2*)(AS5 + ((size_t)g * S5M + cr) * 768 + i * 16 + 4 * fq) = w; }
                }
            }
    }
};
struct EpiSloc {
    float* SLOC;
    __device__ __forceinline__ void operator()(const Acc& acc, const Unit& u, int wr, int wc, int fr, int fq) const {
#pragma unroll
        for (int ai = 0; ai < 2; ++ai)
#pragma unroll
            for (int m = 0; m < 4; ++m) { const int cr = EPI_ROW(u, ai, m); if (cr < S5CH) { float* rp = SLOC + ((size_t)cr * 16 + u.tag) * 256;
#pragma unroll
                for (int bj = 0; bj < 2; ++bj)
#pragma unroll
                    for (int n = 0; n < 2; ++n) *(f32x4*)(rp + EPI_COL(bj, n)) = acc[ai][bj][m][n]; } }
    }
};
struct EpiY {
    bf16_t* YS5;
    __device__ __forceinline__ void operator()(const Acc& acc, const Unit& u, int wr, int wc, int fr, int fq) const {
#pragma unroll
        for (int ai = 0; ai < 2; ++ai)
#pragma unroll
            for (int m = 0; m < 4; ++m) { const int cr = EPI_ROW(u, ai, m); if (cr < S5CH) {
#pragma unroll
                for (int bj = 0; bj < 2; ++bj)
#pragma unroll
                    for (int n = 0; n < 2; ++n) { const int j = u.pn * 16 + bj * 8 + wc * 2 + n; const f32x4 v = acc[ai][bj][m][n];
                        u32x2 w; w.x = pk2(geluf_(v[0]), geluf_(v[1])); w.y = pk2(geluf_(v[2]), geluf_(v[3]));
                        *(u32x2*)(YS5 + ((size_t)cr * 32 + j) * 256 + u.tag * 16 + 4 * fq) = w; } } }
    }
};
struct EpiGlu {
    const bf16_t* YS5; const float* glub; bf16_t* O;
    __device__ __forceinline__ void operator()(const Acc& acc, const Unit& u, int wr, int wc, int fr, int fq) const {
#pragma unroll
        for (int ai = 0; ai < 2; ++ai)
#pragma unroll
            for (int m = 0; m < 4; ++m) { const int row = EPI_ROW(u, ai, m);
#pragma unroll
                for (int bj = 0; bj < 2; ++bj)
#pragma unroll
                    for (int n = 0; n < 2; ++n) { const int col = EPI_COL(bj, n); const f32x4 v = acc[ai][bj][m][n]; const f32x4 bb = *(const f32x4*)(glub + col);
                        const u32x2 yw = *(const u32x2*)(YS5 + (size_t)row * 256 + col);
                        const float y0 = bflo(yw.x), y1 = bfhi(yw.x), y2 = bflo(yw.y), y3 = bfhi(yw.y);
                        u32x2 w; w.x = pk2(y0 * sigmoidf_(v[0] + bb[0]), y1 * sigmoidf_(v[1] + bb[1])); w.y = pk2(y2 * sigmoidf_(v[2] + bb[2]), y3 * sigmoidf_(v[3] + bb[3]));
                        *(u32x2*)(O + (size_t)row * 1024 + 512 + col) = w; }
                if (m & 1) asm volatile("" ::: "memory"); }
    }
};
struct EpiMerge {
    bf16_t* outp; mutable u32x2 S[2][4][2]; mutable u32x2 M[2][4][2];
    __device__ __forceinline__ void operator()(const Acc& acc, const Unit& u, int wr, int wc, int fr, int fq) const {
        if (u.kind == 0) {
#pragma unroll
            for (int ai = 0; ai < 2; ++ai)
#pragma unroll
                for (int m = 0; m < 4; ++m)
#pragma unroll
                    for (int n = 0; n < 2; ++n) { const f32x4 a = acc[ai][0][m][n]; S[ai][m][n] = (u32x2){pk2(sigmoidf_(a[0]), sigmoidf_(a[1])), pk2(sigmoidf_(a[2]), sigmoidf_(a[3]))}; }
        } else {
            const int gate = u.tag;
#pragma unroll
            for (int ai = 0; ai < 2; ++ai)
#pragma unroll
                for (int m = 0; m < 4; ++m)
#pragma unroll
                    for (int n = 0; n < 2; ++n) { const u32x2 w = S[ai][m][n]; const f32x4 a = acc[ai][0][m][n]; const u32x2 mo = M[ai][m][n];
                        f32x4 r = (f32x4){bflo(w.x) * a[0], bfhi(w.x) * a[1], bflo(w.y) * a[2], bfhi(w.y) * a[3]};
                        if (gate > 0) r += (f32x4){bflo(mo.x), bfhi(mo.x), bflo(mo.y), bfhi(mo.y)};
                        const u32x2 o = (u32x2){pk2(r[0], r[1]), pk2(r[2], r[3])}; M[ai][m][n] = o;
                        if (gate == 3) *(u32x2*)(outp + (size_t)EPI_ROW(u, ai, m) * 1024 + u.pn * 128 + wc * 32 + n * 16 + 4 * fq) = o; }
        }
    }
};
#define MFMA16(a, b, c) __builtin_amdgcn_mfma_f32_16x16x32_bf16((a), (b), (c), 0, 0, 0)
template <int NH> struct AttnState { bf16x8 q[NH][2]; f32x4 o[NH][4]; float m[NH], l[NH]; };

template <int NH> __device__ __forceinline__ void attn_init(AttnState<NH>& st) {
#pragma unroll
    for (int h = 0; h < NH; ++h) { st.m[h] = -INFINITY; st.l[h] = 0.f;
#pragma unroll
        for (int d = 0; d < 4; ++d) st.o[h][d] = (f32x4){0.f, 0.f, 0.f, 0.f}; }
}
struct AttnFrag { bf16x8 ka0, ka1, kb0, kb1; s16x4 vlo[4], vhi[4]; };
__device__ __forceinline__ void attn_load(AttnFrag& f, const bf16_t* kr0, const bf16_t* kr1, const bf16_t* vlo, const bf16_t* vhi, size_t dstride) {
    f.ka0 = *(const bf16x8*)(kr0); f.ka1 = *(const bf16x8*)(kr0 + 32); f.kb0 = *(const bf16x8*)(kr1); f.kb1 = *(const bf16x8*)(kr1 + 32);
#pragma unroll
    for (int d = 0; d < 4; ++d) { f.vlo[d] = *(const s16x4*)(vlo + d * dstride); f.vhi[d] = *(const s16x4*)(vhi + d * dstride); }
}
template <int NH, class BiasF>
__device__ __forceinline__ void attn_compute(AttnState<NH>& st, const AttnFrag& f, const BiasF& bias) {
    bf16x8 vf[4];
#pragma unroll
    for (int d = 0; d < 4; ++d) vf[d] = __builtin_shufflevector(f.vlo[d], f.vhi[d], 0, 1, 2, 3, 4, 5, 6, 7);
#pragma unroll
    for (int h = 0; h < NH; ++h) {
        const f32x4 z4 = (f32x4){0.f, 0.f, 0.f, 0.f};
        f32x4 s0 = MFMA16(f.ka0, st.q[h][0], z4); s0 = MFMA16(f.ka1, st.q[h][1], s0);
        f32x4 s1 = MFMA16(f.kb0, st.q[h][0], z4); s1 = MFMA16(f.kb1, st.q[h][1], s1);
        float x[8];
#pragma unroll
        for (int e = 0; e < 4; ++e) { x[e] = bias(h, 0, e, s0[e]); x[4 + e] = bias(h, 1, e, s1[e]); }
        float mx = fmaxf(fmaxf(fmaxf(x[0], x[1]), fmaxf(x[2], x[3])), fmaxf(fmaxf(x[4], x[5]), fmaxf(x[6], x[7])));
        mx = fmaxf(mx, __shfl_xor(mx, 16)); mx = fmaxf(mx, __shfl_xor(mx, 32));
        const float mn = fmaxf(st.m[h], mx); const float alpha = fast_exp2(st.m[h] - mn);
        float p[8]; float ls = 0.f;
#pragma unroll
        for (int e = 0; e < 8; ++e) { p[e] = fast_exp2(x[e] - mn); ls += p[e]; }
        ls += __shfl_xor(ls, 16); ls += __shfl_xor(ls, 32);
        st.l[h] = st.l[h] * alpha + ls; st.m[h] = mn;
        u32x4 pw; pw.x = pk2(p[0], p[1]); pw.y = pk2(p[2], p[3]); pw.z = pk2(p[4], p[5]); pw.w = pk2(p[6], p[7]);
        const bf16x8 pf = __builtin_bit_cast(bf16x8, pw);
#pragma unroll
        for (int d = 0; d < 4; ++d) { st.o[h][d] = st.o[h][d] * alpha; st.o[h][d] = MFMA16(vf[d], pf, st.o[h][d]); }
    }
}
template <int NH, class B0, class B1>
__device__ __forceinline__ void attn_compute2(AttnState<NH>& st, const AttnFrag& f0, const B0& bias0, const AttnFrag& f1, const B1& bias1) {
    bf16x8 v0[4], v1[4];
#pragma unroll
    for (int d = 0; d < 4; ++d) { v0[d] = __builtin_shufflevector(f0.vlo[d], f0.vhi[d], 0, 1, 2, 3, 4, 5, 6, 7); v1[d] = __builtin_shufflevector(f1.vlo[d], f1.vhi[d], 0, 1, 2, 3, 4, 5, 6, 7); }
#pragma unroll
    for (int h = 0; h < NH; ++h) {
        const f32x4 z4 = (f32x4){0.f, 0.f, 0.f, 0.f};
        f32x4 s00 = MFMA16(f0.ka0, st.q[h][0], z4); s00 = MFMA16(f0.ka1, st.q[h][1], s00);
        f32x4 s01 = MFMA16(f0.kb0, st.q[h][0], z4); s01 = MFMA16(f0.kb1, st.q[h][1], s01);
        f32x4 s10 = MFMA16(f1.ka0, st.q[h][0], z4); s10 = MFMA16(f1.ka1, st.q[h][1], s10);
        f32x4 s11 = MFMA16(f1.kb0, st.q[h][0], z4); s11 = MFMA16(f1.kb1, st.q[h][1], s11);
        float x[16];
#pragma unroll
        for (int e = 0; e < 4; ++e) { x[e] = bias0(h, 0, e, s00[e]); x[4 + e] = bias0(h, 1, e, s01[e]); x[8 + e] = bias1(h, 0, e, s10[e]); x[12 + e] = bias1(h, 1, e, s11[e]); }
        float mx = fmaxf(fmaxf(fmaxf(x[0], x[1]), fmaxf(x[2], x[3])), fmaxf(fmaxf(x[4], x[5]), fmaxf(x[6], x[7])));
        mx = fmaxf(mx, fmaxf(fmaxf(fmaxf(x[8], x[9]), fmaxf(x[10], x[11])), fmaxf(fmaxf(x[12], x[13]), fmaxf(x[14], x[15]))));
        mx = fmaxf(mx, __shfl_xor(mx, 16)); mx = fmaxf(mx, __shfl_xor(mx, 32));
        const float mn = fmaxf(st.m[h], mx); const float alpha = fast_exp2(st.m[h] - mn);
        float p[16]; float ls0 = 0.f, ls1 = 0.f;
#pragma unroll
        for (int e = 0; e < 8; ++e) { p[e] = fast_exp2(x[e] - mn); ls0 += p[e]; p[8 + e] = fast_exp2(x[8 + e] - mn); ls1 += p[8 + e]; }
        float ls = ls0 + ls1;
        ls += __shfl_xor(ls, 16); ls += __shfl_xor(ls, 32);
        st.l[h] = st.l[h] * alpha + ls; st.m[h] = mn;
        u32x4 pw; pw.x = pk2(p[0], p[1]); pw.y = pk2(p[2], p[3]); pw.z = pk2(p[4], p[5]); pw.w = pk2(p[6], p[7]);
        u32x4 pv; pv.x = pk2(p[8], p[9]); pv.y = pk2(p[10], p[11]); pv.z = pk2(p[12], p[13]); pv.w = pk2(p[14], p[15]);
        const bf16x8 pf0 = __builtin_bit_cast(bf16x8, pw), pf1 = __builtin_bit_cast(bf16x8, pv);
#pragma unroll
        for (int d = 0; d < 4; ++d) { st.o[h][d] = st.o[h][d] * alpha; st.o[h][d] = MFMA16(v0[d], pf0, st.o[h][d]); st.o[h][d] = MFMA16(v1[d], pf1, st.o[h][d]); }
    }
}
template <int NH> __device__ __forceinline__ void attn_store(const AttnState<NH>& st, bf16_t* O, int qrow, int col0, int quad) {
#pragma unroll
    for (int h = 0; h < NH; ++h) { const float inv = 1.0f / st.l[h];
#pragma unroll
        for (int d = 0; d < 4; ++d) { const f32x4 v = st.o[h][d] * inv; u32x2 w; w.x = pk2(v[0], v[1]); w.y = pk2(v[2], v[3]);
            *(u32x2*)(O + (size_t)qrow * 1024 + col0 + h * 64 + d * 16 + 4 * quad) = w; } }
}
struct BiasNone { __device__ __forceinline__ float operator()(int, int, int, float s) const { return s * SC2; } };

struct BiasNA { const LAS float* rpb; int kc0, qc, cs, rowoff;
    __device__ __forceinline__ float operator()(int, int ti, int e, float s) const {
        const int kc = kc0 + 16 * ti + e; const bool ok = (kc >= cs) && (kc <= cs + 15);
        int bi = kc - qc + 15; bi = bi < 0 ? 0 : (bi > 30 ? 30 : bi);
        const float bv = rpb[rowoff * 31 + bi];
        return ok ? s * SC2 + bv : -INFINITY; } };
struct BiasNA2 { const LAS unsigned char* tab; int off[8]; int rowb;
    __device__ __forceinline__ float operator()(int, int ti, int e, float s) const { return fmaf(s, SC2, *(const LAS float*)(tab + off[ti * 4 + e] + rowb)); } };
__device__ __forceinline__ void na_unit(int u, const bf16_t* Z, const bf16_t* VTL, const bf16_t* VTC, bf16_t* O, const LAS float* rpb, int lane) {
    const int w4 = u & 3, h = (u >> 2) & 3, r = (u >> 4) & 127, b = u >> 11, l16 = lane & 15, quad = lane >> 4;
    const int q0 = b * SEQ + r * 64 + 16 * w4;
    AttnState<1> st; attn_init<1>(st);
    { const bf16_t* qp = Z + (size_t)(q0 + l16) * ZC + ZQA + h * 64 + quad * 8; st.q[0][0] = *(const bf16x8*)qp; st.q[0][1] = *(const bf16x8*)(qp + 32); }
#pragma unroll 1
    for (int s4 = 0; s4 < 8; s4 += 4) { AttnFrag f[4];
#pragma unroll
        for (int j = 0; j < 4; ++j) { const int s = s4 + j;
            const bf16_t* kr0 = Z + (size_t)(NLAT + b * CTXL + 32 * s + l16) * ZC + ZKA + h * 64 + quad * 8;
            const bf16_t* vt = VTC + ((size_t)((b * 6 + h) * 64 + l16)) * CTXL + 32 * s + 4 * quad;
            attn_load(f[j], kr0, kr0 + 16 * ZC, vt, vt + 16, (size_t)16 * CTXL); }
        asm volatile("" ::: "memory");
#pragma unroll
        for (int j = 0; j < 4; ++j) attn_compute<1>(st, f[j], BiasNone());
    }
    const int rs = min(max(r - 4, 0), 120); const int ksw = (w4 == 0) ? 0 : (w4 == 1 ? 8 : (w4 == 2 ? 24 : 32));
    const int qc = 16 * w4 + l16; const int cs = min(max(qc - 8, 0), 48);
#pragma unroll 1
    for (int k4 = 0; k4 < 8; k4 += 4) { AttnFrag f[4];
#pragma unroll
        for (int j = 0; j < 4; ++j) { const int rabs = rs + k4 + j; const int tok0 = b * SEQ + rabs * 64 + ksw;
            const bf16_t* kr0 = Z + (size_t)(tok0 + l16) * ZC + ZKA + h * 64 + quad * 8;
            const bf16_t* vt = VTL + ((size_t)((b * 6 + h) * 64 + l16)) * SEQ + rabs * 64 + ksw + 4 * quad;
            attn_load(f[j], kr0, kr0 + 16 * ZC, vt, vt + 16, (size_t)16 * SEQ); }
        asm volatile("" ::: "memory");
#pragma unroll
        for (int j = 0; j < 4; ++j) { const BiasNA bf{rpb + h * 465, ksw + 4 * quad, qc, cs, rs + k4 + j - r + 7}; attn_compute<1>(st, f[j], bf); }
    }
    attn_store<1>(st, O, q0 + l16, 0 + h * 64, quad);
}
struct BiasSWA { int kpos0, qpos;
    __device__ __forceinline__ float operator()(int, int ti, int e, float s) const {
        const int kpos = kpos0 + 16 * ti + e; const int d = kpos - qpos;
        const bool ok = (kpos >= 0) && (kpos < SEQ) && (d <= 128) && (d >= -128);
        return ok ? s * SC2 : -INFINITY; } };
__device__ __forceinline__ void swa_unit(int u, const bf16_t* Z, const bf16_t* VTL, const bf16_t* VTC, bf16_t* O, const float* sink, int lane) {
    const int hk = u & 1, tile = u >> 1, l16 = lane & 15, quad = lane >> 4;
    const int q0 = tile * 16, b = q0 >> 13, t0 = q0 & (SEQ - 1);
    AttnState<2> st; attn_init<2>(st);
#pragma unroll
    for (int h = 0; h < 2; ++h) { const bf16_t* qp = Z + (size_t)(q0 + l16) * ZC + ZQD + (2 * hk + h) * 64 + quad * 8; st.q[h][0] = *(const bf16x8*)qp; st.q[h][1] = *(const bf16x8*)(qp + 32); }
#pragma unroll 1
    for (int s4 = 0; s4 < 8; s4 += 4) { AttnFrag f[4];
#pragma unroll
        for (int j = 0; j < 4; ++j) { const int s = s4 + j;
            const bf16_t* kr0 = Z + (size_t)(NLAT + b * CTXL + 32 * s + l16) * ZC + ZKD + hk * 64 + quad * 8;
            const bf16_t* vt = VTC + ((size_t)((b * 6 + 4 + hk) * 64 + l16)) * CTXL + 32 * s + 4 * quad;
            attn_load(f[j], kr0, kr0 + 16 * ZC, vt, vt + 16, (size_t)16 * CTXL); }
        asm volatile("" ::: "memory");
#pragma unroll
        for (int j = 0; j < 4; ++j) attn_compute<2>(st, f[j], BiasNone());
    }
    const bf16_t* vrow = VTL + ((size_t)((b * 6 + 4 + hk) * 64 + l16)) * SEQ;
#pragma unroll 1
    for (int s3 = 0; s3 < 9; s3 += 3) { AttnFrag f[3];
#pragma unroll
        for (int j = 0; j < 3; ++j) { const int kb = t0 - 128 + 32 * (s3 + j);
            const int k0 = min(max(kb + l16, 0), SEQ - 1), k1 = min(max(kb + 16 + l16, 0), SEQ - 1);
            const int v0 = min(max(kb + 4 * quad, 0), SEQ - 4), v1 = min(max(kb + 16 + 4 * quad, 0), SEQ - 4);
            attn_load(f[j], Z + (size_t)(b * SEQ + k0) * ZC + ZKD + hk * 64 + quad * 8, Z + (size_t)(b * SEQ + k1) * ZC + ZKD + hk * 64 + quad * 8, vrow + v0, vrow + v1, (size_t)16 * SEQ); }
        asm volatile("" ::: "memory");
#pragma unroll
        for (int j = 0; j < 3; ++j) { const BiasSWA bf{t0 - 128 + 32 * (s3 + j) + 4 * quad, t0 + l16}; attn_compute<2>(st, f[j], bf); }
    }
#pragma unroll
    for (int h = 0; h < 2; ++h) st.l[h] += fast_exp2(sink[2 * hk + h] * LOG2E - st.m[h]);
    attn_store<2>(st, O, q0 + l16, 768 + 2 * hk * 64, quad);
}
__device__ __forceinline__ void ctx_unit(int u, const bf16_t* Z, const bf16_t* VTC, bf16_t* O, const float* sink, int lane) {
    const int l16 = lane & 15, quad = lane >> 4;
    if (u < 256) {
        const int h = u & 3, qt = (u >> 2) & 15, b = u >> 6; const int q0 = NLAT + b * CTXL + 16 * qt;
        AttnState<1> st; attn_init<1>(st);
        { const bf16_t* qp = Z + (size_t)(q0 + l16) * ZC + ZQA + h * 64 + quad * 8; st.q[0][0] = *(const bf16x8*)qp; st.q[0][1] = *(const bf16x8*)(qp + 32); }
#pragma unroll 1
        for (int s4 = 0; s4 < 8; s4 += 4) { AttnFrag f[4];
#pragma unroll
            for (int j = 0; j < 4; ++j) { const int s = s4 + j;
                const bf16_t* kr0 = Z + (size_t)(NLAT + b * CTXL + 32 * s + l16) * ZC + ZKA + h * 64 + quad * 8;
                const bf16_t* vt = VTC + ((size_t)((b * 6 + h) * 64 + l16)) * CTXL + 32 * s + 4 * quad;
                attn_load(f[j], kr0, kr0 + 16 * ZC, vt, vt + 16, (size_t)16 * CTXL); }
            asm volatile("" ::: "memory");
#pragma unroll
            for (int j = 0; j < 4; ++j) attn_compute<1>(st, f[j], BiasNone());
        }
        attn_store<1>(st, O, q0 + l16, h * 64, quad);
    } else {
        const int v = u - 256; const int hk = v & 1, qt = (v >> 1) & 15, b = v >> 5; const int q0 = NLAT + b * CTXL + 16 * qt;
        AttnState<2> st; attn_init<2>(st);
#pragma unroll
        for (int h = 0; h < 2; ++h) { const bf16_t* qp = Z + (size_t)(q0 + l16) * ZC + ZQD + (2 * hk + h) * 64 + quad * 8; st.q[h][0] = *(const bf16x8*)qp; st.q[h][1] = *(const bf16x8*)(qp + 32); }
#pragma unroll 1
        for (int s4 = 0; s4 < 8; s4 += 4) { AttnFrag f[4];
#pragma unroll
            for (int j = 0; j < 4; ++j) { const int s = s4 + j;
                const bf16_t* kr0 = Z + (size_t)(NLAT + b * CTXL + 32 * s + l16) * ZC + ZKD + hk * 64 + quad * 8;
                const bf16_t* vt = VTC + ((size_t)((b * 6 + 4 + hk) * 64 + l16)) * CTXL + 32 * s + 4 * quad;
                attn_load(f[j], kr0, kr0 + 16 * ZC, vt, vt + 16, (size_t)16 * CTXL); }
            asm volatile("" ::: "memory");
#pragma unroll
            for (int j = 0; j < 4; ++j) attn_compute<2>(st, f[j], BiasNone());
        }
#pragma unroll
        for (int h = 0; h < 2; ++h) st.l[h] += fast_exp2(sink[2 * hk + h] * LOG2E - st.m[h]);
        attn_store<2>(st, O, q0 + l16, 768 + 2 * hk * 64, quad);
    }
}

__device__ __forceinline__ void gmlp_unit(int u, LAS unsigned char* lds, const bf16_t* Z, bf16_t* O, const bf16_t* gws  , const float* gbs  ,
                                          const float* lng, const float* lnb, int wave, int lane) {
    LAS bf16_t* VB = (LAS bf16_t*)lds;
    const int row0 = u * 128, l16 = lane & 15, quad = lane >> 4;
    const f32x4 g4 = *(const f32x4*)(lng + 4 * lane), b4 = *(const f32x4*)(lnb + 4 * lane);
    bf16x8 aw[4][4];
#pragma unroll
    for (int g = 0; g < 4; ++g)
#pragma unroll
        for (int ks = 0; ks < 4; ++ks) aw[g][ks] = *(const bf16x8*)(gws + ((size_t)(g * 128 + 16 * wave + l16)) * 128 + 32 * ks + 8 * quad);
#pragma unroll 1
    for (int bt = 0; bt < 2; ++bt) {
        const int jb = 2 * wave + bt; float v[8][4];
#pragma unroll
        for (int t = 0; t < 8; ++t) { const u32x2 raw = *(const u32x2*)(Z + (size_t)(row0 + 8 * jb + t) * ZC + ZGV + 4 * lane);
            v[t][0] = geluf_(bflo(raw.x)); v[t][1] = geluf_(bfhi(raw.x)); v[t][2] = geluf_(bflo(raw.y)); v[t][3] = geluf_(bfhi(raw.y)); }
#pragma unroll
        for (int t = 0; t < 8; ++t) {
            const float mean = wave_sum((v[t][0] + v[t][1]) + (v[t][2] + v[t][3])) * (1.0f / 256.0f);
            float d0 = v[t][0] - mean, d1 = v[t][1] - mean, d2 = v[t][2] - mean, d3 = v[t][3] - mean;
            const float var = wave_sum((d0 * d0 + d1 * d1) + (d2 * d2 + d3 * d3)) * (1.0f / 256.0f);
            const float rstd = 1.0f / sqrtf(var + EPS);
            v[t][0] = d0 * rstd * g4[0] + b4[0]; v[t][1] = d1 * rstd * g4[1] + b4[1]; v[t][2] = d2 * rstd * g4[2] + b4[2]; v[t][3] = d3 * rstd * g4[3] + b4[3];
        }
#pragma unroll
        for (int q = 0; q < 4; ++q) { u32x4 w; w.x = pk2(v[0][q], v[1][q]); w.y = pk2(v[2][q], v[3][q]); w.z = pk2(v[4][q], v[5][q]); w.w = pk2(v[6][q], v[7][q]);
            *(LAS u32x4*)(VB + ((size_t)(jb * 256 + 4 * lane + q)) * 8) = w; }
    }
    __syncthreads();
#pragma unroll
    for (int g = 0; g < 4; ++g) {
        const bf16x8 (&a)[4] = aw[g];
#pragma unroll
        for (int ct = 0; ct < 4; ++ct) {
            f32x4 acc = (f32x4){0.f, 0.f, 0.f, 0.f};
#pragma unroll
            for (int ks = 0; ks < 4; ++ks) { const bf16x8 bb = *(const LAS bf16x8*)(VB + ((size_t)((4 * ks + quad) * 256 + g * 64 + 16 * ct + l16)) * 8); acc = MFMA16(bb, a[ks], acc); }
            const int i = 16 * wave + l16, c0 = g * 64 + 16 * ct + 4 * quad; const size_t row = (size_t)(row0 + i);
            const float bs = gbs[g * 128 + i]; const u32x2 uw = *(const u32x2*)(Z + row * ZC + ZGU + c0);
            u32x2 o; o.x = pk2(geluf_(bflo(uw.x)) * (acc[0] + bs), geluf_(bfhi(uw.x)) * (acc[1] + bs)); o.y = pk2(geluf_(bflo(uw.y)) * (acc[2] + bs), geluf_(bfhi(uw.y)) * (acc[3] + bs));
            *(u32x2*)(O + row * 1024 + 256 + c0) = o;
        }
    }
    __syncthreads();
}

__device__ __forceinline__ void s5_build(int l, int g, int part, LAS unsigned char* lds, KArgs A, bf16_t* TGp, bf16_t* WS5p, int tid) {
    LAS f32x2* Apow = (LAS f32x2*)lds;
    LAS f32x2* Bb = Apow + 2 * 33 * 64;
    LAS f32x2* Cc = Bb + 2 * 64 * 16;
    LAS f32x2* Kc = Cc + 2 * 16 * 64;
    LAS float* Kt = (LAS float*)(Kc + 128);
    if (tid < 128) {
        const int dir = tid >> 6, p = tid & 63; const int ix = ((l * 2 + dir) * 16 + g) * 64 + p;
        const float lre = fminf(A->in[I_ARE][ix], -1e-4f), lim = A->in[I_AIM][ix]; const float dt = expf(A->in[I_LDT][(l * 2 + dir) * 16 + g]);
        for (int k = 0; k <= 32; ++k) { const float mag = expf(lre * dt * (float)k), ang = lim * dt * (float)k; Apow[(dir * 33 + k) * 64 + p] = (f32x2){mag * cosf(ang), mag * sinf(ang)}; }
        const float mag = expf(lre * dt), abr = mag * cosf(lim * dt), abi = mag * sinf(lim * dt); const float den = lre * lre + lim * lim;
        Kc[dir * 64 + p] = (f32x2){((abr - 1.0f) * lre + abi * lim) / den, (abi * lre - (abr - 1.0f) * lim) / den};
    }
    __syncthreads();
    for (int x = tid; x < 2048; x += 512) {
        { const int dir = x >> 10, p = (x >> 4) & 63, c = x & 15; const int ix = (((l * 2 + dir) * 16 + g) * 64 + p) * 16 + c; const float br = A->in[I_BRE][ix], bi = A->in[I_BIM][ix]; const f32x2 k = Kc[dir * 64 + p];
          Bb[x] = (f32x2){k.x * br - k.y * bi, k.x * bi + k.y * br}; }
        { const int dir = x >> 10, cp = (x >> 6) & 15, p = x & 63; const int ix = (((l * 2 + dir) * 16 + g) * 16 + cp) * 64 + p; Cc[x] = (f32x2){A->in[I_CRE][ix], A->in[I_CIM][ix]}; }
    }
    __syncthreads();
    for (int x4 = tid; x4 < 4096; x4 += 512) {
        const int dir = x4 >> 11, k = (x4 >> 6) & 31, cp = 4 * part + ((x4 >> 4) & 3), c = x4 & 15; const int x = ((dir * 32 + k) * 16 + cp) * 16 + c; float s = 0.f;
        for (int p = 0; p < 64; ++p) { const f32x2 cc = Cc[(dir * 16 + cp) * 64 + p], a = Apow[(dir * 33 + k) * 64 + p], bb = Bb[(dir * 64 + p) * 16 + c];
            const float er = cc.x * a.x - cc.y * a.y, ei = cc.x * a.y + cc.y * a.x; s += er * bb.x - ei * bb.y; }
        Kt[x] = s;
    }
    __syncthreads();
    const float* dvec = A->in[I_D] + l * 256 + g * 16;
    bf16_t* tg = TGp + ((size_t)(l * 16 + g)) * 512 * 768;
    for (int x = tid; x < 128 * 96; x += 512) {
        const int nr = x / 96, ch = x % 96, j = nr >> 2, cp = 4 * part + (nr & 3), n = j * 16 + cp; float o[8];
        if (ch < 64) { const int i = ch >> 1, c0 = (ch & 1) * 8;
#pragma unroll
            for (int q = 0; q < 8; ++q) { const int c = c0 + q; float v = 0.f;
                if (i <= j) v += Kt[((0 * 32 + (j - i)) * 16 + cp) * 16 + c];
                if (i >= j) v += Kt[((1 * 32 + (i - j)) * 16 + cp) * 16 + c];
                if (i == j && c == cp) v += dvec[cp];
                o[q] = v; }
        } else { const int kk = (ch - 64) * 8; const int dir = kk >> 7, ri = (kk >> 6) & 1, p0 = kk & 63; const int pw = dir == 0 ? (j + 1) : (32 - j);
#pragma unroll
            for (int q = 0; q < 8; ++q) { const int p = p0 + q; const f32x2 cc = Cc[(dir * 16 + cp) * 64 + p], a = Apow[(dir * 33 + pw) * 64 + p];
                const float er = cc.x * a.x - cc.y * a.y, ei = cc.x * a.y + cc.y * a.x; o[q] = ri == 0 ? er : -ei; }
        }
        u32x4 w; w.x = pk2(o[0], o[1]); w.y = pk2(o[2], o[3]); w.z = pk2(o[4], o[5]); w.w = pk2(o[6], o[7]);
        *(u32x4*)(tg + (size_t)n * 768 + ch * 8) = w;
    }
    bf16_t* wsp = WS5p + ((size_t)(l * 16 + g)) * 256 * 512;
    for (int x = tid; x < 64 * 64; x += 512) {
        const int n = 64 * part + (x >> 6), ch = x & 63, dir = n >> 7, ri = (n >> 6) & 1, p = n & 63, i = ch >> 1, c0 = (ch & 1) * 8; const int pw = dir == 0 ? (31 - i) : i;
        const f32x2 a = Apow[(dir * 33 + pw) * 64 + p]; float o[8];
#pragma unroll
        for (int q = 0; q < 8; ++q) { const f32x2 bb = Bb[(dir * 64 + p) * 16 + c0 + q]; o[q] = ri == 0 ? (a.x * bb.x - a.y * bb.y) : (a.x * bb.y + a.y * bb.x); }
        u32x4 w; w.x = pk2(o[0], o[1]); w.y = pk2(o[2], o[3]); w.z = pk2(o[4], o[5]); w.w = pk2(o[6], o[7]);
        *(u32x4*)(wsp + (size_t)n * 512 + ch * 8) = w;
    }
    __syncthreads();
}
__device__ __forceinline__ void s5_carry(int id, int l, KArgs A, const float* SLOCp, bf16_t* AS5p) {
    const int p = id & 63, dir = (id >> 6) & 1, g = (id >> 7) & 15, b = id >> 11; const int ix = ((l * 2 + dir) * 16 + g) * 64 + p;
    const float lre = fminf(A->in[I_ARE][ix], -1e-4f), lim = A->in[I_AIM][ix]; const float dt = expf(A->in[I_LDT][(l * 2 + dir) * 16 + g]);
    const float mag = expf(lre * dt * 32.0f), ang = lim * dt * 32.0f; const float ar = mag * cosf(ang), ai = mag * sinf(ang);
    float hr = 0.f, hi = 0.f;
    for (int blk = 0; blk < 33; ++blk) {
        float sr[8], si[8]; int crs[8];
#pragma unroll
        for (int q = 0; q < 8; ++q) { const int o = blk * 8 + q; int cr;
            if (o < 8) cr = 1024 + b * 8 + (dir == 0 ? o : 7 - o); else { const int k = o - 8; cr = b * 256 + (dir == 0 ? k : 255 - k); }
            crs[q] = cr; const float* sp = SLOCp + ((size_t)cr * 16 + g) * 256 + dir * 128 + p; sr[q] = sp[0]; si[q] = sp[64]; }
#pragma unroll
        for (int q = 0; q < 8; ++q) { bf16_t* hp = AS5p + ((size_t)g * S5M + crs[q]) * 768 + 512 + dir * 128 + p; hp[0] = (bf16_t)f2bf(hr); hp[64] = (bf16_t)f2bf(hi);
            const float nr = ar * hr - ai * hi + sr[q], ni = ar * hi + ai * hr + si[q]; hr = nr; hi = ni; }
    }
}

constexpr int AT_STAGE = 32768, AT_NST = 4, AT_RPB = 131072 + 1024;
__device__ __forceinline__ void at_dma(LAS unsigned char* lds, int buf, const bf16_t* K0, const bf16_t* K1, const bf16_t* V0, const bf16_t* V1, size_t vpitch, int wave, int lane) {
    const int hh = wave >> 2; const bf16_t* Kb = hh ? K1 : K0; const bf16_t* Vb = hh ? V1 : V0;
#pragma unroll
    for (int i = 0; i < 4; ++i) { const int j = (wave & 3) * 4 + i, kv = j >> 3, sub = j & 7; const int r = sub * 8 + (lane >> 3), cg = (lane & 7) ^ (r & 7);
        const bf16_t* src = kv ? Vb + (size_t)r * vpitch + cg * 8 : Kb + (size_t)r * ZC + cg * 8;
        __builtin_amdgcn_global_load_lds((const unsigned*)src, (LAS unsigned*)(lds + buf * AT_STAGE + hh * 16384 + kv * 8192 + sub * 1024), 16, 0, 0); }
}
__device__ __forceinline__ void at_frag(AttnFrag& f, const LAS unsigned char* tb, int kb, int l16, int quad) {
    const int r0 = kb + l16, r1 = kb + 16 + l16;
    f.ka0 = *(const LAS bf16x8*)(tb + r0 * 128 + ((quad ^ (r0 & 7)) << 4)); f.ka1 = *(const LAS bf16x8*)(tb + r0 * 128 + (((4 + quad) ^ (r0 & 7)) << 4));
    f.kb0 = *(const LAS bf16x8*)(tb + r1 * 128 + ((quad ^ (r1 & 7)) << 4)); f.kb1 = *(const LAS bf16x8*)(tb + r1 * 128 + (((4 + quad) ^ (r1 & 7)) << 4));
    const int ko = kb + 4 * quad, ko2 = ko + 16;
#pragma unroll
    for (int d = 0; d < 4; ++d) { const int r = d * 16 + l16;
        f.vlo[d] = *(const LAS s16x4*)(tb + 8192 + r * 128 + (((ko >> 3) ^ (r & 7)) << 4) + (ko & 7) * 2);
        f.vhi[d] = *(const LAS s16x4*)(tb + 8192 + r * 128 + (((ko2 >> 3) ^ (r & 7)) << 4) + (ko2 & 7) * 2); }
}
#define AT_WAIT_BAR(n) asm volatile("s_waitcnt vmcnt(" #n ")\n\ts_barrier" ::: "memory")
__device__ __forceinline__ void na_unit2(int u, LAS unsigned char* lds, const bf16_t* Z, const bf16_t* VTL, const bf16_t* VTC, bf16_t* O, int wave, int lane) {
    asm volatile("" : "+v"(lane));
    const int hp = u & 1, r = (u >> 1) & 127, b = u >> 8, hh = wave >> 2, w4 = wave & 3, h = 2 * hp + hh; int l16 = lane & 15, quad = lane >> 4;
    const LAS float* rpb = (const LAS float*)(lds + AT_RPB);
    const int q0 = b * SEQ + r * 64 + 16 * w4;
    AttnState<1> st; attn_init<1>(st);
    { const bf16_t* qp = Z + (size_t)(q0 + l16) * ZC + ZQA + h * 64 + quad * 8; st.q[0][0] = *(const bf16x8*)qp; st.q[0][1] = *(const bf16x8*)(qp + 32); }
    const int rs = min(max(r - 4, 0), 120); const int ksw = (w4 == 0) ? 0 : (w4 == 1 ? 8 : (w4 == 2 ? 24 : 32));
    const int qc = 16 * w4 + l16; const int cs = min(max(qc - 8, 0), 48);
    const bf16_t* Kc = Z + (size_t)(NLAT + b * CTXL) * ZC + ZKA + 2 * hp * 64; const bf16_t* Vc = VTC + ((size_t)((b * 6 + 2 * hp) * 64)) * CTXL;
    const bf16_t* Kw = Z + (size_t)(b * SEQ + rs * 64) * ZC + ZKA + 2 * hp * 64; const bf16_t* Vw = VTL + ((size_t)((b * 6 + 2 * hp) * 64)) * SEQ + rs * 64;
    at_dma(lds, 0, Kc, Kc + 64, Vc, Vc + (size_t)64 * CTXL, CTXL, wave, lane);
    at_dma(lds, 1, Kc + (size_t)64 * ZC, Kc + (size_t)64 * ZC + 64, Vc + 64, Vc + (size_t)64 * CTXL + 64, CTXL, wave, lane);
#pragma unroll 1
    for (int j = 0; j < 6; ++j) {
        AT_WAIT_BAR(0);
        asm volatile("" : "+v"(lane), "+v"(l16), "+v"(quad));
        const int sa = (j & 1) * 2;
        if (j == 0) { at_dma(lds, 2, Kc + (size_t)128 * ZC, Kc + (size_t)128 * ZC + 64, Vc + 128, Vc + (size_t)64 * CTXL + 128, CTXL, wave, lane);
                      at_dma(lds, 3, Kc + (size_t)192 * ZC, Kc + (size_t)192 * ZC + 64, Vc + 192, Vc + (size_t)64 * CTXL + 192, CTXL, wave, lane); }
        else if (j < 5) { const int k = 2 * j - 2;
            at_dma(lds, sa ^ 2, Kw + (size_t)64 * k * ZC, Kw + (size_t)64 * k * ZC + 64, Vw + 64 * k, Vw + (size_t)64 * SEQ + 64 * k, SEQ, wave, lane);
            at_dma(lds, (sa ^ 2) + 1, Kw + (size_t)64 * (k + 1) * ZC, Kw + (size_t)64 * (k + 1) * ZC + 64, Vw + 64 * (k + 1), Vw + (size_t)64 * SEQ + 64 * (k + 1), SEQ, wave, lane); }
        const LAS unsigned char* ta = lds + sa * AT_STAGE + hh * 16384; const LAS unsigned char* tb = ta + AT_STAGE; AttnFrag fa, fb;
        if (j < 2) { at_frag(fa, ta, 0, l16, quad); at_frag(fb, ta, 32, l16, quad); attn_compute2<1>(st, fa, BiasNone(), fb, BiasNone());
                     at_frag(fa, tb, 0, l16, quad); at_frag(fb, tb, 32, l16, quad); attn_compute2<1>(st, fa, BiasNone(), fb, BiasNone()); }
        else { const int kr = 2 * (j - 2); at_frag(fa, ta, ksw, l16, quad); at_frag(fb, tb, ksw, l16, quad);
            const BiasNA b0{rpb + h * 465, ksw + 4 * quad, qc, cs, rs + kr - r + 7}; const BiasNA b1{rpb + h * 465, ksw + 4 * quad, qc, cs, rs + kr + 1 - r + 7};
            attn_compute2<1>(st, fa, b0, fb, b1); }
    }
    attn_store<1>(st, O, q0 + l16, h * 64, quad);
    __builtin_amdgcn_s_barrier();
}
__device__ __forceinline__ void na_unit3(int u, LAS unsigned char* lds, const bf16_t* Z, const bf16_t* VTL, const bf16_t* VTC, bf16_t* O, int wave, int lane) {
    asm volatile("" : "+v"(lane));
    const int hp = u & 1, rp = (u >> 1) & 63, b = u >> 7, hh = wave >> 2, w4 = wave & 3, h = 2 * hp + hh; int l16 = lane & 15, quad = lane >> 4;
    const int r0 = 2 * rp, r1 = r0 + 1; const int q0 = b * SEQ + r0 * 64 + 16 * w4;
    AttnState<1> s0, s1; attn_init<1>(s0); attn_init<1>(s1);
    { const bf16_t* qp = Z + (size_t)(q0 + l16) * ZC + ZQA + h * 64 + quad * 8; s0.q[0][0] = *(const bf16x8*)qp; s0.q[0][1] = *(const bf16x8*)(qp + 32);
      const bf16_t* qq = qp + (size_t)64 * ZC; s1.q[0][0] = *(const bf16x8*)qq; s1.q[0][1] = *(const bf16x8*)(qq + 32); }
    const int rs0 = min(max(r0 - 4, 0), 120), rs1 = min(max(r1 - 4, 0), 120), dd = rs1 - rs0, nwin = 8 + dd, nt = 4 + nwin, nit = (nt + 1) >> 1;
    const int ksw = (w4 == 0) ? 0 : (w4 == 1 ? 8 : (w4 == 2 ? 24 : 32));
    const int qc = 16 * w4 + l16; const int cs = min(max(qc - 8, 0), 48);
    BiasNA2 bna; bna.tab = (const LAS unsigned char*)(lds + AT_RPB); bna.rowb = 0;
#pragma unroll
    for (int j = 0; j < 8; ++j) { const int kc = ksw + 4 * quad + 16 * (j >> 2) + (j & 3); const bool ok = (kc >= cs) && (kc <= cs + 15); int bi = kc - qc + 15; bi = bi < 0 ? 0 : (bi > 30 ? 30 : bi); bna.off[j] = (h * 480 + (ok ? bi : 31)) * 4; }
    const bf16_t* Kc = Z + (size_t)(NLAT + b * CTXL) * ZC + ZKA + 2 * hp * 64; const bf16_t* Vc = VTC + ((size_t)((b * 6 + 2 * hp) * 64)) * CTXL;
    const bf16_t* Kw = Z + (size_t)(b * SEQ + rs0 * 64) * ZC + ZKA + 2 * hp * 64; const bf16_t* Vw = VTL + ((size_t)((b * 6 + 2 * hp) * 64)) * SEQ + rs0 * 64;
    at_dma(lds, 0, Kc, Kc + 64, Vc, Vc + (size_t)64 * CTXL, CTXL, wave, lane);
    at_dma(lds, 1, Kc + (size_t)64 * ZC, Kc + (size_t)64 * ZC + 64, Vc + 64, Vc + (size_t)64 * CTXL + 64, CTXL, wave, lane);
#pragma unroll 1
    for (int j = 0; j < nit; ++j) {
        AT_WAIT_BAR(0);
        asm volatile("" : "+v"(lane), "+v"(l16), "+v"(quad));
        const int sa = (j & 1) * 2;
#pragma unroll
        for (int tt = 0; tt < 2; ++tt) { const int n = 2 * j + 2 + tt;
            if (n < nt) { if (n < 4) at_dma(lds, (sa ^ 2) + tt, Kc + (size_t)64 * n * ZC, Kc + (size_t)64 * n * ZC + 64, Vc + 64 * n, Vc + (size_t)64 * CTXL + 64 * n, CTXL, wave, lane);
                          else { const int k = n - 4; at_dma(lds, (sa ^ 2) + tt, Kw + (size_t)64 * k * ZC, Kw + (size_t)64 * k * ZC + 64, Vw + 64 * k, Vw + (size_t)64 * SEQ + 64 * k, SEQ, wave, lane); } } }
        const LAS unsigned char* ta = lds + sa * AT_STAGE + hh * 16384; const LAS unsigned char* tb = ta + AT_STAGE; AttnFrag fa, fb;
        if (j < 2) { at_frag(fa, ta, 0, l16, quad); at_frag(fb, ta, 32, l16, quad); attn_compute2<1>(s0, fa, BiasNone(), fb, BiasNone()); attn_compute2<1>(s1, fa, BiasNone(), fb, BiasNone());
                     at_frag(fa, tb, 0, l16, quad); at_frag(fb, tb, 32, l16, quad); attn_compute2<1>(s0, fa, BiasNone(), fb, BiasNone()); attn_compute2<1>(s1, fa, BiasNone(), fb, BiasNone()); }
        else { const int ka = 2 * (j - 2), kb = ka + 1; const bool hasb = kb < nwin;
            at_frag(fa, ta, ksw, l16, quad); if (hasb) at_frag(fb, tb, ksw, l16, quad);
            { const bool va = ka <= 7, vb = hasb && kb <= 7;
              BiasNA2 ba = bna, bb = bna; ba.rowb = (rs0 + ka - r0 + 7) * 128; bb.rowb = ba.rowb + 128;
              if (va && vb) attn_compute2<1>(s0, fa, ba, fb, bb); else if (va) attn_compute<1>(s0, fa, ba); else if (vb) attn_compute<1>(s0, fb, bb); }
            { const bool va = ka >= dd, vb = hasb && kb <= dd + 7;
              BiasNA2 ba = bna, bb = bna; ba.rowb = (rs0 + ka - r1 + 7) * 128; bb.rowb = ba.rowb + 128;
              if (va && vb) attn_compute2<1>(s1, fa, ba, fb, bb); else if (va) attn_compute<1>(s1, fa, ba); else if (vb) attn_compute<1>(s1, fb, bb); } }
    }
    attn_store<1>(s0, O, q0 + l16, h * 64, quad); attn_store<1>(s1, O, q0 + 64 + l16, h * 64, quad);
    __builtin_amdgcn_s_barrier();
}
__device__ __forceinline__ void swa_unit2(int u, LAS unsigned char* lds, const bf16_t* Z, const bf16_t* VTL, const bf16_t* VTC, bf16_t* O, const float* sink, int wave, int lane) {
    asm volatile("" : "+v"(lane));
    const int qb = u & 127, b = u >> 7, hk = wave >> 2, j4 = wave & 3; int l16 = lane & 15, quad = lane >> 4;
    const int tb0 = qb * 64, t0 = tb0 + 16 * j4, q0 = b * SEQ + t0;
    AttnState<2> st; attn_init<2>(st);
#pragma unroll
    for (int h = 0; h < 2; ++h) { const bf16_t* qp = Z + (size_t)(q0 + l16) * ZC + ZQD + (2 * hk + h) * 64 + quad * 8; st.q[h][0] = *(const bf16x8*)qp; st.q[h][1] = *(const bf16x8*)(qp + 32); }
    const int wlo = tb0 >= 128 ? 0 : (128 - tb0) / 64; int whi = (SEQ - tb0 + 128) / 64; whi = whi > 5 ? 5 : whi; const int ns = 4 + whi - wlo;
    const bf16_t* Kc = Z + (size_t)(NLAT + b * CTXL) * ZC + ZKD; const bf16_t* Vc = VTC + ((size_t)((b * 6 + 4) * 64)) * CTXL;
    const int key00 = tb0 - 128 + 64 * wlo;
    const bf16_t* Kw = Z + (size_t)(b * SEQ + key00) * ZC + ZKD; const bf16_t* Vw = VTL + ((size_t)((b * 6 + 4) * 64)) * SEQ + key00;
    at_dma(lds, 0, Kc, Kc + 64, Vc, Vc + (size_t)64 * CTXL, CTXL, wave, lane);
    at_dma(lds, 1, Kc + (size_t)64 * ZC, Kc + (size_t)64 * ZC + 64, Vc + 64, Vc + (size_t)64 * CTXL + 64, CTXL, wave, lane);
    const int nit = (ns + 1) >> 1;
#pragma unroll 1
    for (int j = 0; j < nit; ++j) {
        AT_WAIT_BAR(0);
        asm volatile("" : "+v"(lane), "+v"(l16), "+v"(quad));
        const int sa = (j & 1) * 2;
        if (j == 0) { at_dma(lds, 2, Kc + (size_t)128 * ZC, Kc + (size_t)128 * ZC + 64, Vc + 128, Vc + (size_t)64 * CTXL + 128, CTXL, wave, lane);
                      at_dma(lds, 3, Kc + (size_t)192 * ZC, Kc + (size_t)192 * ZC + 64, Vc + 192, Vc + (size_t)64 * CTXL + 192, CTXL, wave, lane); }
        else { const int k = 2 * j - 2;
            if (k + 4 < ns) at_dma(lds, sa ^ 2, Kw + (size_t)64 * k * ZC, Kw + (size_t)64 * k * ZC + 64, Vw + 64 * k, Vw + (size_t)64 * SEQ + 64 * k, SEQ, wave, lane);
            if (k + 5 < ns) at_dma(lds, (sa ^ 2) + 1, Kw + (size_t)64 * (k + 1) * ZC, Kw + (size_t)64 * (k + 1) * ZC + 64, Vw + 64 * (k + 1), Vw + (size_t)64 * SEQ + 64 * (k + 1), SEQ, wave, lane); }
        const LAS unsigned char* ta = lds + sa * AT_STAGE + hk * 16384; AttnFrag fa, fb;
        if (j < 2) { at_frag(fa, ta, 0, l16, quad); at_frag(fb, ta, 32, l16, quad); attn_compute2<2>(st, fa, BiasNone(), fb, BiasNone());
                     at_frag(fa, ta + AT_STAGE, 0, l16, quad); at_frag(fb, ta + AT_STAGE, 32, l16, quad); attn_compute2<2>(st, fa, BiasNone(), fb, BiasNone()); }
        else {
#pragma unroll
            for (int tt = 0; tt < 2; ++tt) { const int s = 2 * j + tt;
                if (s < ns) { const LAS unsigned char* tb = ta + tt * AT_STAGE; const int key0 = key00 + 64 * (s - 4);
                    const bool ok0 = (key0 + 31 >= t0 - 128) && (key0 <= t0 + 15 + 128), ok1 = (key0 + 63 >= t0 - 128) && (key0 + 32 <= t0 + 15 + 128);
                    if (ok0 && ok1) { at_frag(fa, tb, 0, l16, quad); at_frag(fb, tb, 32, l16, quad);
                        const BiasSWA b0{key0 + 4 * quad, t0 + l16}; const BiasSWA b1{key0 + 32 + 4 * quad, t0 + l16}; attn_compute2<2>(st, fa, b0, fb, b1); }
                    else if (ok0) { at_frag(fa, tb, 0, l16, quad); const BiasSWA b0{key0 + 4 * quad, t0 + l16}; attn_compute<2>(st, fa, b0); }
                    else if (ok1) { at_frag(fa, tb, 32, l16, quad); const BiasSWA b1{key0 + 32 + 4 * quad, t0 + l16}; attn_compute<2>(st, fa, b1); } } }
        }
    }
#pragma unroll
    for (int h = 0; h < 2; ++h) st.l[h] += fast_exp2(sink[2 * hk + h] * LOG2E - st.m[h]);
    attn_store<2>(st, O, q0 + l16, 768 + 2 * hk * 64, quad);
    __builtin_amdgcn_s_barrier();
}
struct Row16 { f32x4 v[4]; };
__device__ __forceinline__ Row16 row_load_f32(const float* p, int lane) { Row16 r; const f32x4* q = (const f32x4*)p + lane;
#pragma unroll
    for (int j = 0; j < 4; ++j) r.v[j] = q[64 * j]; return r; }
__device__ __forceinline__ void row_store_f32(float* p, const Row16& r, int lane) { f32x4* q = (f32x4*)p + lane;
#pragma unroll
    for (int j = 0; j < 4; ++j) q[64 * j] = r.v[j]; }
__device__ __forceinline__ Row16 row_load_bf16(const bf16_t* p, int lane) { Row16 r; const u32x2* q = (const u32x2*)p + lane;
#pragma unroll
    for (int j = 0; j < 4; ++j) { const u32x2 w = q[64 * j]; r.v[j] = (f32x4){bflo(w.x), bfhi(w.x), bflo(w.y), bfhi(w.y)}; } return r; }
__device__ __forceinline__ void row_store_bf16(bf16_t* p, const Row16& r, int lane) { u32x2* q = (u32x2*)p + lane;
#pragma unroll
    for (int j = 0; j < 4; ++j) { u32x2 w; w.x = pk2(r.v[j][0], r.v[j][1]); w.y = pk2(r.v[j][2], r.v[j][3]); q[64 * j] = w; } }
__device__ __forceinline__ float row_rstd(const Row16& r) { float s = 0.f;
#pragma unroll
    for (int j = 0; j < 4; ++j) s += (r.v[j][0] * r.v[j][0] + r.v[j][1] * r.v[j][1]) + (r.v[j][2] * r.v[j][2] + r.v[j][3] * r.v[j][3]);
    return 1.0f / sqrtf(wave_sum(s) * (1.0f / DM) + EPS); }
__device__ __forceinline__ Row16 row_norm_mod(const Row16& x, const float* g, const float* sc, const float* sh, int lane) {
    const float rstd = row_rstd(x); Row16 y; const f32x4* gq = (const f32x4*)g + lane; const f32x4* scq = (const f32x4*)sc + lane; const f32x4* shq = (const f32x4*)sh + lane;
#pragma unroll
    for (int j = 0; j < 4; ++j) y.v[j] = x.v[j] * rstd * gq[64 * j] * (scq[64 * j] + 1.0f) + shq[64 * j];
    return y; }
__device__ __forceinline__ Row16 row_resid(const Row16& x, const Row16& f, const float* g, const float* gate, int lane) {
    const float rstd = row_rstd(f); Row16 y; const f32x4* gq = (const f32x4*)g + lane; const f32x4* gt = (const f32x4*)gate + lane;
#pragma unroll
    for (int j = 0; j < 4; ++j) y.v[j] = x.v[j] + gt[64 * j] * (f.v[j] * rstd * gq[64 * j]);
    return y; }

__device__ __forceinline__ Row16 row_norm_mod_t(const Row16& x, const Row16& g, const Row16& sc, const Row16& sh) {
    const float rstd = row_rstd(x); Row16 y;
#pragma unroll
    for (int j = 0; j < 4; ++j) y.v[j] = x.v[j] * rstd * g.v[j] * (sc.v[j] + 1.0f) + sh.v[j];
    return y; }
__device__ __forceinline__ Row16 row_resid_t(const Row16& x, const Row16& f, const Row16& g, const Row16& gate) {
    const float rstd = row_rstd(f); Row16 y;
#pragma unroll
    for (int j = 0; j < 4; ++j) y.v[j] = x.v[j] + gate.v[j] * (f.v[j] * rstd * g.v[j]);
    return y; }
template <int MODE> __device__ __forceinline__ int tr_dest_row(int c, int p0) {
    if (MODE == 0) return p0 + c;
    if (MODE == 3) return p0 + (c & ~31) + 16 * ((c >> 2) & 1) + 4 * ((c >> 3) & 3) + (c & 3);
    if (MODE == 1) return 256 * (c >> 6) + 128 * (p0 >> 1) + 32 * ((c >> 4) & 3) + 16 * (p0 & 1) + (c & 15);
    return 256 * (c >> 7) + 128 * ((c >> 2) & 1) + 32 * ((c >> 5) & 3) + 16 * p0 + 4 * ((c >> 3) & 3) + (c & 3);
}
template <int MODE> __device__ __forceinline__ void tr_item(const float* W, int ld, int col0  , int c0  , int k0,
                                                            bf16_t* WT, int ldd, int koff, int p0, LAS float* scr, int lane) {
#pragma unroll 8
    for (int i = 0; i < 32; ++i) { const int kk = 2 * i + (lane >> 5); scr[kk * 33 + (lane & 31)] = W[(size_t)(k0 + kk) * ld + col0 + (lane & 31)]; }
    asm volatile("s_waitcnt lgkmcnt(0)" ::: "memory");
    const int c = lane & 7;
#pragma unroll
    for (int j = 0; j < 4; ++j) { const int n = (lane >> 3) + 8 * j; const LAS float* s = scr + (8 * c) * 33 + n;
        u32x4 o; o.x = pk2(s[0 * 33], s[1 * 33]); o.y = pk2(s[2 * 33], s[3 * 33]); o.z = pk2(s[4 * 33], s[5 * 33]); o.w = pk2(s[6 * 33], s[7 * 33]);
        *(u32x4*)(WT + (size_t)tr_dest_row<MODE>(c0 + n, p0) * ldd + koff + k0 + 8 * c) = o; }
    asm volatile("s_waitcnt lgkmcnt(0)" ::: "memory");
}
template <int MODE> __device__ __forceinline__ void tr_item8(const float* W, int ld, int col0, int c0, int k0, unsigned char* WT, int ldd, int p0, float scale, LAS float* scr, int lane) {
#pragma unroll 8
    for (int i = 0; i < 32; ++i) { const int kk = 2 * i + (lane >> 5); scr[kk * 33 + (lane & 31)] = W[(size_t)(k0 + kk) * ld + col0 + (lane & 31)]; }
    asm volatile("s_waitcnt lgkmcnt(0)" ::: "memory");
    const int c = lane & 7;
#pragma unroll
    for (int j = 0; j < 4; ++j) { const int n = (lane >> 3) + 8 * j; const LAS float* sp = scr + (8 * c) * 33 + n;
        u32x2 o; o.x = pk4_fp8(sp[0 * 33] * scale, sp[1 * 33] * scale, sp[2 * 33] * scale, sp[3 * 33] * scale); o.y = pk4_fp8(sp[4 * 33] * scale, sp[5 * 33] * scale, sp[6 * 33] * scale, sp[7 * 33] * scale);
        *(u32x2*)(WT + (size_t)tr_dest_row<MODE>(c0 + n, p0) * ldd + k0 + 8 * c) = o; }
    asm volatile("s_waitcnt lgkmcnt(0)" ::: "memory");
}
__device__ __forceinline__ int zmap(int c) {
    if (c < 512) return c;
    if (c < 768) return 1536 + (c - 512);
    if (c < 1024) return 512 + (c - 768);
    if (c < 1152) return 1280 + (c - 1024);
    if (c < 1280) return 1408 + (c - 1152);
    if (c < 1792) return 768 + (c - 1280);
    return c;
}
constexpr int PH_PER_LAYER = 32, N_PHASES = 1 + 2 * PH_PER_LAYER;
__device__ __forceinline__ void moe_load(LAS int* base, const LAS int* grp, int q, int tid) {
    __syncthreads();
    if (tid < 9) base[tid] = grp[16 + q * 16 + tid];
    if (tid == 16) base[16] = grp[0];
    if (tid == 17) base[17] = grp[1 + q];
    if (tid == 18) base[18] = grp[2 + q];
    if (tid == 19) base[19] = q > 0 ? grp[q] : 0;
    __syncthreads();
}
__device__ __forceinline__ KArgs kargs() { KArgs p = (KArgs)__builtin_amdgcn_kernarg_segment_ptr(); asm volatile("" : "+s"(p)); return p; }
#define PHASE_PTRS int tid; asm volatile("v_mbcnt_lo_u32_b32 %0, -1, 0\n\tv_mbcnt_hi_u32_b32 %0, -1, %0" : "=v"(tid)); tid += wave_s * 64; asm volatile("" : "+v"(tid)); const int lane = tid & 63, wave = __builtin_amdgcn_readfirstlane(tid >> 6); const int gw = bx * 8 + wave; (void)lane; (void)gw; KArgs A = kargs(); unsigned char* const ws = A->ws; float* const out = A->out; (void)out; unsigned* const ctl = (unsigned*)(ws + WS_CTL); (void)ctl; float* const MOD = (float*)(ws + WS_MOD); (void)MOD
#define ROPEC ((float*)(ws + WS_ROPE))
#define ROPES (ROPEC + 2048)
#define TOPI ((int*)(ws + WS_TOPI))
#define TOPW ((float*)(ws + WS_TOPW))
#define SLOT ((int*)(ws + WS_SLOT))
#define ROWTOK ((int*)(ws + WS_ROWTOK))
#define WCNT ((int*)(ws + WS_WCNT))
#define GRP ((int*)(ws + WS_GRP))
#define GLUT ((bf16_t*)(ws + WS_GLUT))
#define GWS ((bf16_t*)(ws + WS_GWS))
#define WS5 ((bf16_t*)(ws + WS_WS5))
#define TG ((bf16_t*)(ws + WS_TG))
#define WIN_T ((bf16_t*)(ws + WS_WIN))
#define WG_T ((bf16_t*)(ws + WS_WG))
#define WBR_T ((bf16_t*)(ws + WS_WBR))
#define WOUT_T ((bf16_t*)(ws + WS_WOUT))
#define W13_T ((bf16_t*)(ws + WS_W13))
#define W2_T ((bf16_t*)(ws + WS_W2))
#define MW13_T ((bf16_t*)(ws + WS_MW13))
#define MW2_T ((bf16_t*)(ws + WS_MW2))
#define HCTX ((float*)(ws + WS_HCTX))
#define VTL ((bf16_t*)(ws + WS_VTL))
#define VTC ((bf16_t*)(ws + WS_VTC))
#define HX ((bf16_t*)(ws + WS_HX))
#define Z ((bf16_t*)(ws + WS_Z))
#define O ((bf16_t*)(ws + WS_O))
#define AS5 ((bf16_t*)(ws + WS_AS5))
#define SLOC ((float*)(ws + WS_SLOC))
#define YS5 ((bf16_t*)(ws + WS_YS5))
#define MB ((bf16_t*)(ws + WS_MB))
#define HB ((bf16_t*)(ws + WS_H))
#define MY ((bf16_t*)(ws + WS_MY))
#define MH ((bf16_t*)(ws + WS_MH))
#define PARTB ((float*)(ws + WS_PART))
#define HXM8 ((unsigned char*)(ws + WS_MW13 + 56 * MiB))
#define HX8 ((unsigned char*)(ws + WS_PART))
#define SPLIT_GEMM(EpiT, BaseT, GATH, g, S0, E, ntk) pg8::gemm_phase<EpiT, BaseT, GATH>(lds, g, S0, E, tid)
__global__ void __launch_bounds__(512, 2) fwd(Args args) {
    extern __shared__ __attribute__((aligned(16))) unsigned char lds_raw[];
    LAS unsigned char* lds = (LAS unsigned char*)lds_raw;
    volatile LAS unsigned* MISC = (volatile LAS unsigned*)(lds + MISC_OFF);
    const int G = gridDim.x, bx = blockIdx.x, NGW = G * 8;
    const int vc = (bx & 7) * (G >> 3) + (bx >> 3);
    LAS int* mbase = (LAS int*)(lds + RING_BYTES);

    const int wave_s = __builtin_amdgcn_readfirstlane(threadIdx.x >> 6);
    if (threadIdx.x < 64) MISC[threadIdx.x] = 0u;
    __syncthreads();
#if MK_MULTI
#define SEAM() do { } while (0)
#else
    const XcdBarrier bar = xcd_barrier_post((unsigned*)(args.ws + WS_CTL) + CW_BAR, MISC + 8);
#define SEAM() xcd_barrier(bar, tid)
#endif
#ifndef SITE_MASK
#define SITE_MASK 0xFFFFFFFFu
#endif
#ifndef DUP_MASK
#define DUP_MASK 0u
#endif
#define DUPN(site) ((((DUP_MASK) >> (site)) & 1u) ? 2 : 1)
#define RUN(site, ph) ((((SITE_MASK) >> (site)) & 1u) && args.ph_lo <= (ph) && (ph) < args.ph_hi)

    if (RUN(0, 0)) for (int rep_ = 0; rep_ < DUPN(0); ++rep_) { PHASE_PTRS;
        LAS float* SIL = (LAS float*)lds;
        for (int i = tid; i < 5120; i += 512) { const int bi = i >> 10, k = i & 1023; const float v = bi < 4 ? A->in[I_C][bi * 1024 + k] : A->in[I_CCTX][k]; SIL[i] = siluf_(v); }
        __syncthreads();
        { LAS float* red = (LAS float*)(lds + 24576);
          for (int it = bx; it < 768; it += G) {
            const int l = it / 384, col = (it % 384) * 16 + (lane & 15), kq = lane >> 4; float a[5] = {0.f, 0.f, 0.f, 0.f, 0.f};
            const float* wp = A->in[I_WMOD] + (size_t)l * 1024 * 6144 + col;
#pragma unroll 8
            for (int k = 128 * wave + kq; k < 128 * wave + 128; k += 4) { const float w = wp[(size_t)k * 6144];
#pragma unroll
                for (int b = 0; b < 5; ++b) a[b] += SIL[b * 1024 + k] * w; }
#pragma unroll
            for (int b = 0; b < 5; ++b) { a[b] += __shfl_xor(a[b], 16); a[b] += __shfl_xor(a[b], 32); }
            if (lane < 16) {
#pragma unroll
                for (int b = 0; b < 5; ++b) red[(wave * 5 + b) * 16 + lane] = a[b]; }
            __syncthreads();
            if (tid < 80) { const int b = tid >> 4, c = tid & 15; float sum = 0.f;
#pragma unroll
                for (int w = 0; w < 8; ++w) sum += red[(w * 5 + b) * 16 + c];
                const int cc = (it % 384) * 16 + c; MOD[(l * 5 + b) * 6144 + cc] = sum + A->in[I_BMOD][l * 6144 + cc]; }
            __syncthreads();
          } }
        for (int i = bx * 512 + tid; i < 2048; i += G * 512) { const int pos = i >> 4, f = i & 15; const float inv = powf(10000.0f, -(float)f / 16.0f); const float ang = (float)pos * inv; ROPEC[i] = cosf(ang); ROPES[i] = sinf(ang); }
        for (int i = bx * 512 + tid; i < 131072; i += G * 512) GWS[i] = (bf16_t)f2bf(A->in[I_GWS][i]);
        __syncthreads();
        for (int it = bx; it < 128; it += G) s5_build(it >> 6, (it >> 2) & 15, it & 3, lds, A, TG, WS5, tid);
        __syncthreads();
        LAS float* scr = (LAS float*)(lds + wave * 8448);
        constexpr int T_LAYER = 1024 + 2048 + 512 + 512 + 32, T_FFN = 3 * 1408, T_EXP = 3 * 1792, T_ALL = 2 * T_LAYER + T_FFN + 8 * T_EXP;
        for (int it = gw; it < T_ALL; it += NGW) {
            int r = it;
            if (r < 2 * T_LAYER) { const int l = r / T_LAYER; r %= T_LAYER;
                if (r < 1024) { const int kb = r >> 6, cb = r & 63; if (FP8_P2) tr_item8<0>(A->in[I_WIN] + (size_t)l * 1024 * 6144, 6144, cb * 32, 0, kb * 64, (unsigned char*)(WIN_T + (size_t)l * 2048 * 1024), 1024, zmap(cb * 32), 32.0f, scr, lane); else tr_item<0>(A->in[I_WIN] + (size_t)l * 1024 * 6144, 6144, cb * 32, 0, kb * 64, WIN_T + (size_t)l * 2048 * 1024, 1024, 0, zmap(cb * 32), scr, lane); continue; } r -= 1024;
                if (r < 2048) { const int kb = r >> 7, cb = r & 127; const int i = cb >> 5, c = (cb & 31) * 32; tr_item8<0>(A->in[I_WIN] + (size_t)l * 1024 * 6144, 6144, 2048 + i * 1024 + c, 0, kb * 64, (unsigned char*)(WG_T + (size_t)l * 4096 * 512), 1024, i * 1024 + c, 32.0f, scr, lane); continue; } r -= 2048;
                if (r < 512) { const int i = r >> 7, kb = (r >> 5) & 3, cb = r & 31; tr_item<0>(A->in[I_WBR] + (size_t)(l * 4 + i) * 256 * 1024, 1024, cb * 32, 0, kb * 64, WBR_T + (size_t)l * 4096 * 512, 512, 0, i * 1024 + cb * 32, scr, lane); continue; } r -= 512;
                if (r < 512) { const int kb = r >> 5, cb = r & 31; tr_item<3>(A->in[I_WOUT] + (size_t)l * 1024 * 1024, 1024, cb * 32, 0, kb * 64, WOUT_T + (size_t)l * 1024 * 1024, 1024, 0, cb * 32, scr, lane); continue; } r -= 512;
                { const int kb = r >> 3, cb = r & 7; tr_item<0>(A->in[I_GLUW] + (size_t)l * 65536, 256, cb * 32, 0, kb * 64, GLUT + (size_t)l * 65536, 256, 0, cb * 32, scr, lane); continue; }
            }
            r -= 2 * T_LAYER;
            if (r < T_FFN) {
                if (r < 1408) { const int kb = r / 88, cb = r % 88; if (FP8_FFN_UP) tr_item8<2>(A->in[I_F1], FFN, cb * 32, cb * 32, kb * 64, (unsigned char*)W13_T, 1024, 0, 32.0f, scr, lane); else tr_item<2>(A->in[I_F1], FFN, cb * 32, cb * 32, kb * 64, W13_T, 1024, 0, 0, scr, lane); continue; } r -= 1408;
                if (r < 1408) { const int kb = r / 88, cb = r % 88; if (FP8_FFN_UP) tr_item8<2>(A->in[I_F3], FFN, cb * 32, cb * 32, kb * 64, (unsigned char*)W13_T, 1024, 1, 32.0f, scr, lane); else tr_item<2>(A->in[I_F3], FFN, cb * 32, cb * 32, kb * 64, W13_T, 1024, 0, 1, scr, lane); continue; } r -= 1408;
                { const int kb = r >> 5, cb = r & 31; if (FP8_FFN_DN) tr_item8<3>(A->in[I_F2], 1024, cb * 32, 0, kb * 64, (unsigned char*)W2_T, FFN, cb * 32, 64.0f, scr, lane); else tr_item<3>(A->in[I_F2], 1024, cb * 32, 0, kb * 64, W2_T, FFN, 0, cb * 32, scr, lane); continue; }
            }
            r -= T_FFN;
            { const int e = r / T_EXP; r %= T_EXP;
                if (r < 1792) { const int kb = r / 112, cb = r % 112; tr_item8<2>(A->in[I_M1] + (size_t)e * 1024 * EXD, EXD, cb * 32, cb * 32, kb * 64, (unsigned char*)MW13_T + (size_t)e * 7168 * 1024, 1024, 0, 32.0f, scr, lane); continue; } r -= 1792;
                if (r < 1792) { const int kb = r / 112, cb = r % 112; tr_item8<2>(A->in[I_M3] + (size_t)e * 1024 * EXD, EXD, cb * 32, cb * 32, kb * 64, (unsigned char*)MW13_T + (size_t)e * 7168 * 1024, 1024, 1, 32.0f, scr, lane); continue; } r -= 1792;
                { const int kb = r >> 5, cb = r & 31; tr_item8<3>(A->in[I_M2] + (size_t)e * EXD * 1024, 1024, cb * 32, 0, kb * 64, (unsigned char*)MW2_T + (size_t)e * 1024 * EXD, EXD, cb * 32, 64.0f, scr, lane); continue; }
            }
        }
        SEAM();
    }

#pragma unroll 1
    for (int l = 0; l < 2; ++l) {
        const int P = 1 + l * PH_PER_LAYER;
        const int nrow = (l == 0) ? NROW : NLAT;
        const int nMt = nrow / 256;


        if (l == 0 && RUN(1, P + 0)) for (int rep_ = 0; rep_ < DUPN(1); ++rep_) { PHASE_PTRS;
            { const Row16 Tg = row_load_f32(A->in[I_GPREMIX], lane); Row16 Tsc{}, Tsh{}; int cbi = -1;
              const int r0 = gw * 17, r1 = (r0 + 17 < NROW) ? r0 + 17 : NROW;
              Row16 xn{}; if (r0 < r1) xn = row_load_f32(r0 < NLAT ? A->in[I_X] + (size_t)r0 * DM : A->in[I_CTX] + (size_t)(r0 - NLAT) * DM, lane);
              for (int r = r0; r < r1; ++r) { const int bi = r < NLAT ? (r >> 13) : 4;
                if (bi != cbi) { const float* mb = (MOD + (size_t)l * 5 * 6144) + bi * 6144; Tsc = row_load_f32(mb + 1024, lane); Tsh = row_load_f32(mb, lane); cbi = bi; }
                const Row16 x = xn; const int rn = r + 1;
                if (rn < r1) xn = row_load_f32(rn < NLAT ? A->in[I_X] + (size_t)rn * DM : A->in[I_CTX] + (size_t)(rn - NLAT) * DM, lane);
                const Row16 y = row_norm_mod_t(x, Tg, Tsc, Tsh); row_store_bf16(HX + (size_t)r * DM, y, lane);
                { unsigned* h8 = (unsigned*)(HXM8 + (size_t)r * DM) + lane;
#pragma unroll
                  for (int j = 0; j < 4; ++j) h8[64 * j] = pk4_fp8(y.v[j][0], y.v[j][1], y.v[j][2], y.v[j][3]); } } }
            SEAM();
        }
        if (RUN(2, P + 1)) for (int rep_ = 0; rep_ < DUPN(2); ++rep_) { PHASE_PTRS;
            const EpiZ E{Z, VTL, VTC, AS5, ROPEC, ROPES};
            if constexpr (FP8_P2) { const pg8::Gemm g{(const bf16_t*)HXM8, (const bf16_t*)HXM8, WIN_T + (size_t)l * 2048 * 1024, WIN_T, 512, 512, 1024, nullptr, nullptr, 0x7A7A7A7A, 0x7F7F7F7F, 0}; const Sched2D S{132, 8, G, vc, 0, 0, 8, 1};
                pg8::gemm_phase<EpiZ, Sched2D, false, false, true>(lds, g, S, E, tid); }
            else { const pg8::Gemm g{HX, HX, WIN_T + (size_t)l * 2048 * 1024, WIN_T, 1024, 1024, 1024, nullptr, PARTB, 0, 0x7F7F7F7F, 0}; const Sched2D S{132, 8, G, vc, 0, 0, 16, 1};
                pg8::gemm_phase<EpiZ, Sched2D>(lds, g, S, E, tid); }
            SEAM();
        }
        if (RUN(3, P + 2)) for (int rep_ = 0; rep_ < DUPN(3); ++rep_) { PHASE_PTRS;
            { const pg8::Gemm g{AS5, AS5, WS5 + (size_t)l * 16 * 256 * 512, WS5, 768, 512, 512, nullptr, nullptr, 0, 0x7F7F7F7F, 0}; const SchedS5 S{1, G, vc, S5M * 768, 256 * 512, 8}; const EpiSloc E{SLOC};
              pg8::gemm_phase<EpiSloc, SchedS5>(lds, g, S, E, tid); }
            LAS float* rpb = (LAS float*)(lds + AT_RPB);
            for (int i = tid; i < 4 * 480; i += 512) { const int hh_ = i / 480, rem = i % 480, rw = rem >> 5, cl = rem & 31; rpb[i] = (cl < 31) ? A->in[I_RPB][l * 4 * 465 + hh_ * 465 + rw * 31 + cl] * LOG2E : -INFINITY; }
            __syncthreads();
            for (int r2 = 0; r2 < DUPN(17); ++r2) for (int u = G - 1 - bx; u < 512; u += G) na_unit3(u, lds, Z, VTL, VTC, O, wave, lane);
            SEAM();
        }
        if (RUN(4, P + 3)) for (int rep_ = 0; rep_ < DUPN(4); ++rep_) { PHASE_PTRS;
            if (bx < 16) { for (int r2 = 0; r2 < DUPN(16); ++r2) s5_carry(bx * 512 + tid, l, A, SLOC, AS5); }
            else for (int r2 = 0; r2 < DUPN(18); ++r2) for (int u = G - 1 - bx; u < 512; u += G) swa_unit2(u, lds, Z, VTL, VTC, O, A->in[I_SINK] + l * 4, wave, lane);
            SEAM();
        }
        if (RUN(5, P + 4)) for (int rep_ = 0; rep_ < DUPN(5); ++rep_) { PHASE_PTRS;
            { const pg8::Gemm g{AS5, AS5, TG + (size_t)l * 16 * 512 * 768, TG, 768, 768, 768, nullptr, nullptr, 0, 0x7F7F7F7F, 0}; const SchedS5 S{2, G, vc, S5M * 768, 512 * 768, 12}; const EpiY E{YS5};
              pg8::gemm_phase<EpiY, SchedS5>(lds, g, S, E, tid); }
            __syncthreads();
            const int ng = (l == 0) ? 264 : 256; const int fo = (vc >= 160) ? vc - 160 : 96 + vc;
            for (int u = fo; u < ng; u += G) gmlp_unit(u, lds, Z, O, GWS + (size_t)l * 4 * 128 * 128, A->in[I_GBS] + l * 512, A->in[I_LNG] + l * 256, A->in[I_LNB] + l * 256, wave, lane);
            if (fo >= 8 && fo < 40) { const int d = fo - 8; const int u = (G - 1 - (d & 15)) + (d >> 4) * G;
                swa_unit2(u, lds, Z, VTL, VTC, O, A->in[I_SINK] + l * 4, wave, lane); }
            SEAM();
        }
        if (RUN(6, P + 5)) for (int rep_ = 0; rep_ < DUPN(6); ++rep_) { PHASE_PTRS;
            const pg8::Gemm g{YS5, YS5, GLUT + (size_t)l * 65536, GLUT, 256, 256, 256, nullptr, nullptr, 0, 0x7F7F7F7F, 0}; const Sched2D S{nMt, 1, G, vc, 0, 0, 4, 0}; const EpiGlu E{YS5, A->in[I_GLUB] + l * 256, O};
            pg8::gemm_phase<EpiGlu, Sched2D>(lds, g, S, E, tid);
            if (l == 0 && vc >= 208) { const int u = (vc - 208) * 8 + wave; ctx_unit(u, Z, VTC, O, A->in[I_SINK] + l * 4, lane); }
            SEAM();
        }
        if (RUN(7, P + 6)) for (int rep_ = 0; rep_ < DUPN(7); ++rep_) { PHASE_PTRS;
            const pg8::Gemm g{(const bf16_t*)HXM8, O, WG_T + (size_t)l * 4096 * 512, WBR_T + (size_t)l * 4096 * 512, 512, 512, 1024, nullptr, nullptr, 0x7A7A7A7A, 0x7F7F7F7F, 1024}; const SchedMerge S{nMt, G, vc};
            EpiMerge E{}; E.outp = MB;
            pg8::gemm_phase<EpiMerge, SchedMerge, false, true, false, true>(lds, g, S, E, tid);
            SEAM();
        }
        if (RUN(8, P + 7)) for (int rep_ = 0; rep_ < DUPN(8); ++rep_) { PHASE_PTRS;
            const pg8::Gemm g{MB, MB, WOUT_T + (size_t)l * 1024 * 1024, WOUT_T, 1024, 1024, 1024, nullptr, PARTB, 0, 0x7F7F7F7F, 0}; const Sched2D S{128, 4, G, vc, 0, 0, 16, 0}; const EpiPlain E{O, 1024, NROW};
            SPLIT_GEMM(EpiPlain, Sched2D, false, g, S, E, 16);
            SEAM();
        }
        if (RUN(9, P + 8)) for (int rep_ = 0; rep_ < (l == 0 ? DUPN(9) : 1); ++rep_) { PHASE_PTRS;
            LAS float* RT = (LAS float*)lds; LAS int* wcnt = (LAS int*)(lds + 32768);
            if (l == 1) { for (int i = tid; i < 8192; i += 512) RT[i] = A->in[I_RT][i]; if (tid < 8) wcnt[tid] = 0; __syncthreads(); }
            unsigned* tctr = (unsigned*)(ws + WS_CTL) + CW_TAIL;
            if (l == 0 && vc < 16) {
                const pg8::Gemm g{MB, MB, WOUT_T, WOUT_T, 1024, 1024, 1024, nullptr, nullptr, 0, 0x7F7F7F7F, 0}; const Sched2D S{4, 4, G, vc, 0, 0, 16, 0, 128}; const EpiPlain E{O, 1024, NROW};
                pg8::gemm_phase<EpiPlain, Sched2D>(lds, g, S, E, tid);
                tail_signal(tctr, tid);
            }
            const Row16 Tgpost = row_load_f32(A->in[I_GPOSTMIX] + l * DM, lane), Tgpre = row_load_f32(A->in[I_GPREFFN] + l * DM, lane); Row16 Tgate{}, Tsc{}, Tsh{}; int cbi = -1;
#pragma unroll 1
            for (int pass = 0; pass < (l == 0 ? 2 : 1); ++pass) {
            int rbase, nit;
            if (l == 1) { rbase = bx * 128 + wave * 16; nit = 16; }
            else if (pass == 0) { const int nidx = (vc - 16) * 8 + wave; rbase = nidx * 17 + (nidx < 128 ? nidx : 128); nit = (vc < 16) ? 0 : 17 + (nidx < 128 ? 1 : 0); }
            else { tail_wait(tctr, 16u, (unsigned*)(ws + WS_CTL) + CW_BAR, tid); rbase = NLAT + gw; nit = (gw < NROW - NLAT) ? 1 : 0; }
            Row16 xn{}, fn{};
            if (nit > 0 && rbase < nrow) { const float* xq = (l == 0) ? (rbase < NLAT ? A->in[I_X] + (size_t)rbase * DM : A->in[I_CTX] + (size_t)(rbase - NLAT) * DM) : out + (size_t)rbase * DM;
                xn = (l == 1) ? row_load_bf16((const bf16_t*)xq, lane) : row_load_f32(xq, lane); fn = row_load_bf16(O + (size_t)rbase * DM, lane); }
            for (int it = 0; it < nit; ++it) { const int r = rbase + it; if (r >= nrow) break;
                const int bi = r < NLAT ? (r >> 13) : 4; const float* mb = (MOD + (size_t)l * 5 * 6144) + bi * 6144;
                if (bi != cbi) { Tgate = row_load_f32(mb + 2 * 1024, lane); Tsc = row_load_f32(mb + 4 * 1024, lane); Tsh = row_load_f32(mb + 3 * 1024, lane); cbi = bi; }
                float* xo = r < NLAT ? out + (size_t)r * DM : HCTX + (size_t)(r - NLAT) * DM;
                const Row16 x = xn, f = fn;
                { const int rn = r + 1; if (it + 1 < nit && rn < nrow) { const float* xq = (l == 0) ? (rn < NLAT ? A->in[I_X] + (size_t)rn * DM : A->in[I_CTX] + (size_t)(rn - NLAT) * DM) : out + (size_t)rn * DM;
                    xn = (l == 1) ? row_load_bf16((const bf16_t*)xq, lane) : row_load_f32(xq, lane); fn = row_load_bf16(O + (size_t)rn * DM, lane); } }
                const Row16 x1 = row_resid_t(x, f, Tgpost, Tgate); if (r < NLAT) row_store_bf16((bf16_t*)xo, x1, lane); else row_store_f32(xo, x1, lane);
                const Row16 h2 = row_norm_mod_t(x1, Tgpre, Tsc, Tsh); if (l == 0 || FP8_FFN_UP) row_store_bf16(HX + (size_t)r * DM, h2, lane);
                if (l == 1) { unsigned* h8 = (unsigned*)(HX8 + (size_t)r * DM) + lane;
#pragma unroll
                  for (int j = 0; j < 4; ++j) h8[64 * j] = pk4_fp8(h2.v[j][0], h2.v[j][1], h2.v[j][2], h2.v[j][3]); }
                if (l == 1) {
                    float lg[8] = {0.f, 0.f, 0.f, 0.f, 0.f, 0.f, 0.f, 0.f};
#pragma unroll
                    for (int j = 0; j < 4; ++j)
#pragma unroll
                        for (int q = 0; q < 4; ++q) { const int k = 256 * j + 4 * lane + q; const f32x4 w0 = *(const LAS f32x4*)(RT + k * 8), w1 = *(const LAS f32x4*)(RT + k * 8 + 4); const float hv = h2.v[j][q];
                            lg[0] += hv * w0[0]; lg[1] += hv * w0[1]; lg[2] += hv * w0[2]; lg[3] += hv * w0[3]; lg[4] += hv * w1[0]; lg[5] += hv * w1[1]; lg[6] += hv * w1[2]; lg[7] += hv * w1[3]; }
#pragma unroll
                    for (int e = 0; e < 8; ++e) lg[e] = wave_sum(lg[e]);
                    int i0 = 0; float v0 = lg[0];
#pragma unroll
                    for (int e = 1; e < 8; ++e) if (lg[e] > v0) { v0 = lg[e]; i0 = e; }
                    int i1 = -1; float v1 = -INFINITY;
#pragma unroll
                    for (int e = 0; e < 8; ++e) if (e != i0 && lg[e] > v1) { v1 = lg[e]; i1 = e; }
                    const float w0 = 1.0f / (1.0f + __expf(v1 - v0)), w1 = 1.0f - w0;
                    if (lane == 0) { TOPI[2 * r] = i0; TOPI[2 * r + 1] = i1; TOPW[2 * r] = w0; TOPW[2 * r + 1] = w1; __hip_atomic_fetch_add(wcnt + i0, 1, __ATOMIC_RELAXED, __HIP_MEMORY_SCOPE_WORKGROUP); __hip_atomic_fetch_add(wcnt + i1, 1, __ATOMIC_RELAXED, __HIP_MEMORY_SCOPE_WORKGROUP); }
                }
            }
            }
            if (l == 1) { __syncthreads(); if (tid < 8) WCNT[bx * 8 + tid] = wcnt[tid]; }
            SEAM();
        }
        if (l == 0) {
            if (RUN(10, P + 9)) for (int rep_ = 0; rep_ < DUPN(10); ++rep_) { PHASE_PTRS;
                const pg8::Gemm g8{(const bf16_t*)HX8, (const bf16_t*)HX8, W13_T, W13_T, 512, 512, 1024, nullptr, nullptr, 0x7A7A7A7A, 0x7F7F7F7F, 0}; const Sched2D S8{132, 22, G, vc, 0, 0, 8, 2};
                const pg8::Gemm g{HX, HX, W13_T, W13_T, 1024, 1024, 1024, nullptr, nullptr, 0, 0, 0}; const Sched2D S{132, 22, G, vc, 0, 0, 16, 2};
                const EpiSwiglu8 E8{(unsigned char*)HB, FFN}; const EpiSwiglu E{HB, FFN};
                if constexpr (FP8_FFN_UP) { if constexpr (FP8_FFN_DN) pg8::gemm_phase<EpiSwiglu8, Sched2D, false, false, true>(lds, g8, S8, E8, tid); else pg8::gemm_phase<EpiSwiglu, Sched2D, false, false, true>(lds, g8, S8, E, tid); }
                else { if constexpr (FP8_FFN_DN) pg8::gemm_phase<EpiSwiglu8, Sched2D>(lds, g, S, E8, tid); else pg8::gemm_phase<EpiSwiglu, Sched2D>(lds, g, S, E, tid); }
                SEAM();
            }
            if (RUN(11, P + 10)) for (int rep_ = 0; rep_ < DUPN(11); ++rep_) { PHASE_PTRS;
                const EpiPlain E{HX, 1024, NROW};
                if constexpr (FP8_FFN_DN) { const pg8::Gemm g{HB, HB, W2_T, W2_T, FFN / 2, FFN / 2, FFN, nullptr, nullptr, 0x79797979, 0x7C7C7C7C, 0}; const Sched2D S{128, 4, G, vc, 0, 0, 22, 0}; pg8::gemm_phase<EpiPlain, Sched2D, false, false, true>(lds, g, S, E, tid); }
                else { const pg8::Gemm g{HB, HB, W2_T, W2_T, FFN, FFN, FFN, nullptr, nullptr, 0, 0, 0}; const Sched2D S{128, 4, G, vc, 0, 0, 44, 0}; pg8::gemm_phase<EpiPlain, Sched2D>(lds, g, S, E, tid); }
                SEAM();
            }
            if (RUN(12, P + 11)) for (int rep_ = 0; rep_ < DUPN(12); ++rep_) { PHASE_PTRS;
                const float* mod1 = MOD + (size_t)5 * 6144;
                unsigned* tctr = (unsigned*)(ws + WS_CTL) + CW_TAIL + 16;
                if (vc < 16) {
                    const EpiPlain E{HX, 1024, NROW};
                    if constexpr (FP8_FFN_DN) { const pg8::Gemm g{HB, HB, W2_T, W2_T, FFN / 2, FFN / 2, FFN, nullptr, nullptr, 0x79797979, 0x7C7C7C7C, 0}; const Sched2D S{4, 4, G, vc, 0, 0, 22, 0, 128}; pg8::gemm_phase<EpiPlain, Sched2D, false, false, true>(lds, g, S, E, tid); }
                    else { const pg8::Gemm g{HB, HB, W2_T, W2_T, FFN, FFN, FFN, nullptr, nullptr, 0, 0, 0}; const Sched2D S{4, 4, G, vc, 0, 0, 44, 0, 128}; pg8::gemm_phase<EpiPlain, Sched2D>(lds, g, S, E, tid); }
                    tail_signal(tctr, tid);
                }
                { const Row16 Tgf = row_load_f32(A->in[I_GPOSTFFN], lane), Tgm = row_load_f32(A->in[I_GPREMIX] + DM, lane); Row16 Tgate{}, Tsc{}, Tsh{}; int cbi = -1;
#pragma unroll 1
                  for (int pass = 0; pass < 2; ++pass) {
                  int r0, r1;
                  if (pass == 0) { const int nidx = (vc - 16) * 8 + wave; r0 = nidx * 17 + (nidx < 128 ? nidx : 128); r1 = (vc < 16) ? r0 : r0 + 17 + (nidx < 128 ? 1 : 0); }
                  else { tail_wait(tctr, 16u, (unsigned*)(ws + WS_CTL) + CW_BAR, tid); r0 = NLAT + gw; r1 = (gw < NROW - NLAT) ? r0 + 1 : r0; }
                  Row16 xn{}, fn{}; if (r0 < r1) { xn = (r0 < NLAT) ? row_load_bf16((const bf16_t*)(out + (size_t)r0 * DM), lane) : row_load_f32(HCTX + (size_t)(r0 - NLAT) * DM, lane); fn = row_load_bf16(HX + (size_t)r0 * DM, lane); }
                  for (int r = r0; r < r1; ++r) { const int bi = r < NLAT ? (r >> 13) : 4; float* xo = r < NLAT ? out + (size_t)r * DM : HCTX + (size_t)(r - NLAT) * DM;
                    if (bi != cbi) { Tgate = row_load_f32((MOD + (size_t)l * 5 * 6144) + bi * 6144 + 5 * 1024, lane); Tsc = row_load_f32(mod1 + bi * 6144 + 1024, lane); Tsh = row_load_f32(mod1 + bi * 6144, lane); cbi = bi; }
                    const Row16 x = xn, f = fn; const int rn = r + 1;
                    if (rn < r1) { xn = (rn < NLAT) ? row_load_bf16((const bf16_t*)(out + (size_t)rn * DM), lane) : row_load_f32(HCTX + (size_t)(rn - NLAT) * DM, lane); fn = row_load_bf16(HX + (size_t)rn * DM, lane); }
                    const Row16 x2 = row_resid_t(x, f, Tgf, Tgate); if (r < NLAT) row_store_bf16((bf16_t*)xo, x2, lane); else row_store_f32(xo, x2, lane);
                    const Row16 y = row_norm_mod_t(x2, Tgm, Tsc, Tsh); row_store_bf16(HX + (size_t)r * DM, y, lane);
                    { unsigned* h8 = (unsigned*)(HXM8 + (size_t)r * DM) + lane;
#pragma unroll
                      for (int j = 0; j < 4; ++j) h8[64 * j] = pk4_fp8(y.v[j][0], y.v[j][1], y.v[j][2], y.v[j][3]); } } } }
                SEAM();
            }
        } else {
            if (RUN(13, P + 9)) for (int rep_ = 0; rep_ < DUPN(13); ++rep_) { PHASE_PTRS;
                LAS int* gl = (LAS int*)(lds + 512); LAS int* off = (LAS int*)(lds + 2048); LAS int* wv = (LAS int*)(lds + 3072); LAS int* wc = (LAS int*)(lds + 8192); LAS int* PF = (LAS int*)(lds + 16384);
                for (int i = tid; i < 2048; i += 512) wc[i] = WCNT[i];
                __syncthreads();
                { const int e = wave;
                  const int v0 = wc[(4 * lane) * 8 + e], v1 = wc[(4 * lane + 1) * 8 + e], v2 = wc[(4 * lane + 2) * 8 + e], v3 = wc[(4 * lane + 3) * 8 + e];
                  const int tot = v0 + v1 + v2 + v3; int inc = tot;
#pragma unroll
                  for (int o = 1; o < 64; o <<= 1) { const int t = __shfl_up(inc, o); if (lane >= o) inc += t; }
                  const int ex = inc - tot;
                  PF[(4 * lane + 1) * 8 + e] = ex + v0; PF[(4 * lane + 2) * 8 + e] = ex + v0 + v1; PF[(4 * lane + 3) * 8 + e] = ex + v0 + v1 + v2; PF[(4 * lane + 4) * 8 + e] = ex + tot;
                  if (lane == 0) PF[e] = 0; }
                __syncthreads();
                if (tid == 0) { int ng = 0, st = 0;
                    while (st < 256) { int lo = st + 1, hi = 256;
                        while (lo < hi) { const int mid = (lo + hi + 1) >> 1; int tiles = 0;
#pragma unroll
                            for (int e = 0; e < 8; ++e) tiles += (PF[mid * 8 + e] - PF[st * 8 + e] + 255) >> 8;
                            if (tiles <= 64) lo = mid; else hi = mid - 1; }
                        gl[1 + ng] = st; int b = 0;
#pragma unroll
                        for (int e = 0; e < 8; ++e) { gl[16 + ng * 16 + e] = b; b += (PF[lo * 8 + e] - PF[st * 8 + e] + 255) & ~255; }
                        gl[16 + ng * 16 + 8] = b; ++ng; st = lo; }
                    gl[1 + ng] = 256; gl[0] = ng; }
                __syncthreads();
                int gq = 0; while (gl[2 + gq] <= bx) ++gq;
                const int gs = gl[1 + gq], ge = gl[2 + gq];
                if (tid < 8) off[tid] = gl[16 + gq * 16 + tid] + PF[bx * 8 + tid] - PF[gs * 8 + tid];
                int pe = -1, rk = 0;
                if (tid < 256) pe = TOPI[2 * (bx * 128) + tid];
#pragma unroll
                for (int k = 0; k < 8; ++k) { const unsigned long long m = __ballot(pe == k); if (pe == k) rk = __popcll(m & ((1ull << lane) - 1ull)); if (lane == 0 && wave < 4) wv[wave * 8 + k] = __popcll(m); }
                __syncthreads();
                if (tid < 256) { int o = off[pe]; for (int w = 0; w < wave; ++w) o += wv[w * 8 + pe]; const int s_ = o + rk; SLOT[2 * (bx * 128) + tid] = s_; ROWTOK[gq * 16384 + s_] = bx * 128 + (tid >> 1); }
                if (bx == gs) { for (int e = 0; e < 8; ++e) { const int n = PF[ge * 8 + e] - PF[gs * 8 + e];
                        for (int s_ = gl[16 + gq * 16 + e] + n + tid; s_ < gl[16 + gq * 16 + e + 1]; s_ += 512) ROWTOK[gq * 16384 + s_] = bx * 128; } }
                __syncthreads();
                for (int i = tid; i < 16 + 16 * 16; i += 512) { ((LAS int*)(lds + GRPL_OFF))[i] = gl[i]; if (bx == 0) GRP[i] = gl[i]; }
                SEAM();
            }
#pragma unroll 1
            for (int q = 0; q <= 9; ++q) {
                if (RUN(14, P + 10 + 2 * q)) for (int rep_ = 0; rep_ < DUPN(14); ++rep_) { PHASE_PTRS;
                    moe_load(mbase, (const LAS int*)(lds + GRPL_OFF), q, tid); const int ng = mbase[16];
                    if (q <= ng) {
                        if (q > 0) { const int t0 = mbase[19] * 128, t1 = mbase[17] * 128;
                            const Row16 Tgf = row_load_f32(A->in[I_GPOSTFFN] + DM, lane); Row16 Tgate{}; int cbi = -1;
                            for (int t = t0 + gw; t < t1; t += NGW) { const int s0 = SLOT[2 * t], s1 = SLOT[2 * t + 1]; const float w0 = TOPW[2 * t], w1 = TOPW[2 * t + 1];
                                const int bi = t >> 13; if (bi != cbi) { Tgate = row_load_f32((MOD + (size_t)5 * 6144) + bi * 6144 + 5 * 1024, lane); cbi = bi; }
                                const Row16 a = row_load_bf16(MY + (size_t)s0 * DM, lane), b = row_load_bf16(MY + (size_t)s1 * DM, lane); Row16 f;
#pragma unroll
                                for (int j = 0; j < 4; ++j) f.v[j] = a.v[j] * w0 + b.v[j] * w1;
                                const Row16 x = row_load_bf16((const bf16_t*)(out + (size_t)t * DM), lane);
                                const Row16 x2 = row_resid_t(x, f, Tgf, Tgate); row_store_f32(out + (size_t)t * DM, x2, lane); } }
                        if (q < ng) {
                            const pg8::Gemm g{(const bf16_t*)HX8, (const bf16_t*)HX8, MW13_T, MW13_T, 512, 512, 1024, ROWTOK + q * 16384, nullptr, 0x7A7A7A7A, 0x7F7F7F7F, 0}; const SchedMoe S{mbase, 28, G, vc, 7168 * 512, 8}; const EpiSwiglu8 E{(unsigned char*)MH, EXD};
                            pg8::gemm_phase<EpiSwiglu8, SchedMoe, true, false, true>(lds, g, S, E, tid);
                            SEAM(); }
                    }
                }
                if (RUN(15, P + 11 + 2 * q)) for (int rep_ = 0; rep_ < DUPN(15); ++rep_) { PHASE_PTRS;
                    moe_load(mbase, (const LAS int*)(lds + GRPL_OFF), q, tid); const int ng = mbase[16];
                    if (q < ng) {
                        const pg8::Gemm g{MH, MH, MW2_T, MW2_T, EXD / 2, EXD / 2, EXD, nullptr, nullptr, 0x79797979, 0x7C7C7C7C, 0}; const SchedMoe S{mbase, 4, G, vc, 1024 * (EXD / 2), 28}; const EpiPlain E{MY, 1024, 16384};
                        pg8::gemm_phase<EpiPlain, SchedMoe, false, false, true>(lds, g, S, E, tid);
                        SEAM(); }
                }
            }
        }
    }
#undef RUN
#undef SEAM
}

extern "C" void kernel_launch(void* const* d_in, const int* in_sizes, int n_in, void* d_out, int out_size, void* d_ws, size_t ws_size, hipStream_t stream) {
    static int grid = 0;
    if (grid == 0) {
        if (n_in != N_IN || out_size != NLAT * DM || ws_size < WS_END) { fprintf(stderr, "kernel_launch: unexpected problem (n_in %d, out %d, ws %zu); nothing launched\n", n_in, out_size, ws_size); grid = -1; return; }
        int dev = 0, cus = 0, per_cu = 0;
        if (hipGetDevice(&dev) != hipSuccess || hipDeviceGetAttribute(&cus, hipDeviceAttributeMultiprocessorCount, dev) != hipSuccess) { grid = -1; return; }
        if (hipFuncSetAttribute((const void*)fwd, hipFuncAttributeMaxDynamicSharedMemorySize, LDS_BYTES) != hipSuccess) { fprintf(stderr, "kernel_launch: hipFuncSetAttribute failed\n"); grid = -1; return; }
        if (hipOccupancyMaxActiveBlocksPerMultiprocessor(&per_cu, (const void*)fwd, 512, LDS_BYTES) != hipSuccess || per_cu < 1) fprintf(stderr, "kernel_launch: occupancy query reports %d\n", per_cu);
        (void)hipGetLastError();
        if (cus < 256) { fprintf(stderr, "kernel_launch: built for a 256-CU device\n"); grid = -1; return; }
        grid = 256;
    }
    if (grid < 0) return;
    (void)hipMemsetAsync((char*)d_ws + WS_CTL, 0, CTL_ZERO_BYTES, stream);
    Args a{};
    for (int i = 0; i < N_IN; ++i) a.in[i] = (const float*)d_in[i];
    a.out = (float*)d_out; a.ws = (unsigned char*)d_ws;
#if MK_MULTI
    for (int ph = 0; ph < N_PHASES; ++ph) { a.ph_lo = ph; a.ph_hi = ph + 1; hipLaunchKernelGGL(fwd, dim3(grid), dim3(512), LDS_BYTES, stream, a); }
#else
    a.ph_lo = 0; a.ph_hi = N_PHASES;
    hipLaunchKernelGGL(fwd, dim3(grid), dim3(512), LDS_BYTES, stream, a);
#endif
}
```

```cpp
#include <hip/hip_runtime.h>
#include <cstdio>
#include <cstdint>
#include <cmath>

#ifndef FP8_FFN_UP
#define FP8_FFN_UP 0
#endif
#ifndef FP8_FFN_DN
#define FP8_FFN_DN 1
#endif
#ifndef FP8_P2
#define FP8_P2 0
#endif
#ifndef MK_MULTI
#define MK_MULTI 0
#endif

#define LAS __attribute__((address_space(3)))
#define GAS __attribute__((address_space(1)))
typedef unsigned short bf16_t;
typedef short bf16x8 __attribute__((ext_vector_type(8)));
typedef short s16x4 __attribute__((ext_vector_type(4)));
typedef float f32x4 __attribute__((ext_vector_type(4)));
typedef float f32x2 __attribute__((ext_vector_type(2)));
typedef unsigned u32x4 __attribute__((ext_vector_type(4)));
typedef unsigned u32x2 __attribute__((ext_vector_type(2)));
typedef GAS unsigned gu32;
typedef int v8i_t __attribute__((ext_vector_type(8)));
typedef short bf16x16 __attribute__((ext_vector_type(16)));

constexpr int DM = 1024, NBATCH = 4, SEQ = 8192, NLAT = NBATCH * SEQ, CTXL = 256, NCTX = NBATCH * CTXL, NROW = NLAT + NCTX;
constexpr int ZC = 1408;
constexpr int ZQA = 0, ZKA = 256, ZQD = 512, ZGU = 768, ZGV = 1024, ZKD = 1280;
constexpr int FFN = 2816, EXD = 3584, NEXP = 8;
constexpr int S5M = 1280;
constexpr int S5CH = 1056;
constexpr int MOE_ROWS = 16384;
constexpr float EPS = 1e-6f;
constexpr float LOG2E = 1.4426950408889634f;
constexpr float SC2 = 0.125f * LOG2E;

enum { I_X = 0, I_C, I_CTX, I_CCTX, I_WMOD, I_BMOD, I_GPREMIX, I_GPOSTMIX, I_GPREFFN, I_GPOSTFFN, I_WIN, I_RPB, I_SINK, I_LNG, I_LNB, I_GWS, I_GBS,
       I_ARE, I_AIM, I_LDT, I_BRE, I_BIM, I_CRE, I_CIM, I_D, I_GLUW, I_GLUB, I_WBR, I_WOUT, I_F1, I_F3, I_F2, I_RT, I_M1, I_M3, I_M2, N_IN };

constexpr size_t MiB = 1u << 20;
constexpr size_t WS_CTL = 0, CTL_ZERO_BYTES = 1 * MiB;
constexpr size_t WS_MOD = 1 * MiB;
constexpr size_t WS_ROPE = WS_MOD + 256 * 1024;
constexpr size_t WS_TOPI = 2 * MiB;
constexpr size_t WS_TOPW = WS_TOPI + 256 * 1024;
constexpr size_t WS_SLOT = WS_TOPW + 256 * 1024;
constexpr size_t WS_WCNT = WS_SLOT + 256 * 1024;
constexpr size_t WS_GRP = WS_WCNT + 16 * 1024;
constexpr size_t WS_ROWTOK = 3 * MiB;
constexpr size_t WS_GLUT = 4 * MiB;
constexpr size_t WS_GWS = WS_GLUT + 256 * 1024;
constexpr size_t WS_WS5 = 5 * MiB;
constexpr size_t WS_TG = 13 * MiB;
constexpr size_t WS_WIN = 37 * MiB;
constexpr size_t WS_WG = 45 * MiB;
constexpr size_t WS_WBR = 61 * MiB;
constexpr size_t WS_WOUT = 77 * MiB;
constexpr size_t WS_W13 = 81 * MiB;
constexpr size_t WS_W2 = 92 * MiB;
constexpr size_t WS_MW13 = 98 * MiB;
constexpr size_t WS_MW2 = 210 * MiB;
constexpr size_t WS_HCTX = 266 * MiB;
constexpr size_t WS_VTL = 270 * MiB;
constexpr size_t WS_VTC = 294 * MiB;
constexpr size_t WS_HX = 295 * MiB;
constexpr size_t WS_Z = 361 * MiB;
constexpr size_t WS_O = 452 * MiB;
constexpr size_t WS_AS5 = 518 * MiB;
constexpr size_t WS_SLOC = 548 * MiB;
constexpr size_t WS_YS5 = 568 * MiB;
constexpr size_t WS_PART = 548 * MiB;
constexpr size_t WS_END = 612 * MiB;
constexpr size_t WS_SCR = WS_AS5;
constexpr size_t WS_MB = WS_Z;
constexpr size_t WS_H = WS_Z;
constexpr size_t WS_MY = WS_Z;
constexpr size_t WS_MH = WS_Z + 32 * MiB;
static_assert(WS_Z + (size_t)NROW * ZC * 2 <= WS_O && WS_O + (size_t)NROW * 1024 * 2 <= WS_AS5 && WS_YS5 + (size_t)NROW * 256 * 2 <= WS_END && WS_AS5 + (size_t)16 * S5M * 768 * 2 <= WS_PART, "ws map");
static_assert(WS_H + (size_t)NROW * FFN * 2 <= WS_PART && WS_MH + (size_t)MOE_ROWS * EXD * 2 <= WS_PART && WS_PART + 256 * 262144 <= WS_END, "ws map 2");
static_assert(WS_SCR + 256 * 131072 <= WS_YS5, "ws map 3");

constexpr int CW_TMO = 0, CW_BAR = 4096, CW_CNT = 16384, CW_CUR = 16384 + 64, CW_TAIL = 16384 + 256;

constexpr int RING_BYTES = 131072, LDS_BYTES = 147456, MISC_OFF = LDS_BYTES - 256, GRPL_OFF = 131072 + 1024 + 8192;

__device__ __forceinline__ unsigned f2bf(float f) { unsigned u = __builtin_bit_cast(unsigned, f); return (u + 0x7fffu + ((u >> 16) & 1u)) >> 16; }
typedef __bf16 bf16x2_t __attribute__((ext_vector_type(2)));
__device__ __forceinline__ unsigned pk2(float lo, float hi) { const f32x2 v = {lo, hi}; return __builtin_bit_cast(unsigned, __builtin_convertvector(v, bf16x2_t)); }
__device__ __forceinline__ float clamp8(float x) { return __builtin_amdgcn_fmed3f(x, -448.0f, 448.0f); }
__device__ __forceinline__ unsigned pk4_fp8(float a, float b, float c, float d) { int w = 0; w = __builtin_amdgcn_cvt_pk_fp8_f32(clamp8(a), clamp8(b), w, false); w = __builtin_amdgcn_cvt_pk_fp8_f32(clamp8(c), clamp8(d), w, true); return (unsigned)w; }
__device__ __forceinline__ float bf2f(unsigned b) { return __builtin_bit_cast(float, b << 16); }
__device__ __forceinline__ float bflo(unsigned w) { return __builtin_bit_cast(float, w << 16); }
__device__ __forceinline__ float bfhi(unsigned w) { return __builtin_bit_cast(float, w & 0xffff0000u); }
#define DPP_F(v, ctrl) __builtin_bit_cast(float, __builtin_amdgcn_update_dpp(0, __builtin_bit_cast(int, (v)), (ctrl), 0xF, 0xF, true))
__device__ __forceinline__ float wave_sum(float v) {
    v += DPP_F(v, 0xB1); v += DPP_F(v, 0x4E); v += DPP_F(v, 0x124); v += DPP_F(v, 0x128);
    v += __shfl_xor(v, 16); v += __shfl_xor(v, 32);
    return v;
}
__device__ __forceinline__ float fast_exp2(float x) { return __builtin_amdgcn_exp2f(x); }
__device__ __forceinline__ float rcp_(float x) { return __builtin_amdgcn_rcpf(x); }
__device__ __forceinline__ float sigmoidf_(float x) { return rcp_(1.0f + __expf(-x)); }
__device__ __forceinline__ float siluf_(float x) { return x * rcp_(1.0f + __expf(-x)); }
__device__ __forceinline__ float geluf_(float x) {
    const float u = 0.7978845608028654f * (x + 0.044715f * x * x * x);
    return x * rcp_(1.0f + __expf(-2.0f * u));
}

#define XB_TMO      128
#define XB_XCNT(j)  (256  + 64 * (j))
#define XB_XSUB(j)  (1280 + 64 * (j))
#define XB_XGEN(j)  (2304 + 64 * (j))
#define XB_TOP      3328
#define XB_TOPGEN   3392
#define XCD_BAR_WORDS 3456
#define XB_SPIN_CAP (1u << 22)
__device__ __forceinline__ unsigned xb_ld(unsigned* p)              { return __hip_atomic_load(p, __ATOMIC_RELAXED, __HIP_MEMORY_SCOPE_AGENT); }
__device__ __forceinline__ unsigned xb_add(unsigned* p, unsigned v) { return __hip_atomic_fetch_add(p, v, __ATOMIC_RELAXED, __HIP_MEMORY_SCOPE_AGENT); }
__device__ __forceinline__ unsigned xb_xcc_id() { return (unsigned)__builtin_amdgcn_s_getreg((3 << 11) | 20) & 0xFu; }
#define XB_SPIN(cond, bar) do { unsigned _sp = 0; while (cond) { __builtin_amdgcn_s_sleep(1); \
    if ((++_sp & 255u) == 0u) { if (xb_ld(&(bar)[XB_TMO])) break; if (_sp > XB_SPIN_CAP) { atomicAdd(&(bar)[XB_TMO], 1u); break; } } } } while (0)
struct XcdBarrier { unsigned* bar; unsigned x; volatile LAS unsigned* st; };
__device__ __forceinline__ XcdBarrier xcd_barrier_post(unsigned* bar, volatile LAS unsigned* st) {
    XcdBarrier b; b.bar = bar; b.x = xb_xcc_id(); b.st = st;
    if (threadIdx.x == 0) (void)xb_add(&bar[XB_XCNT(b.x)], 1u);
    return b;
}
__device__ __forceinline__ void xcd_barrier_complete(unsigned* bar, unsigned x, unsigned& nloc, unsigned& nx) {
    const unsigned G = gridDim.x * gridDim.y * gridDim.z;
    unsigned sum, cnt, mine, sp = 0u;
    for (;;) {
        sum = 0u; cnt = 0u; mine = 0u;
#pragma unroll
        for (unsigned j = 0; j < 16; ++j) { const unsigned c = xb_ld(&bar[XB_XCNT(j)]); sum += c; cnt += (c > 0u) ? 1u : 0u; mine = (j == x) ? c : mine; }
        if (sum == G) break;
        __builtin_amdgcn_s_sleep(1);
        if ((++sp & 255u) == 0u) { if (xb_ld(&bar[XB_TMO])) break; if (sp > XB_SPIN_CAP) { atomicAdd(&bar[XB_TMO], 1u); break; } }
    }
    nloc = mine > 0u ? mine : 1u; nx = cnt > 0u ? cnt : 1u;
}
__device__ __forceinline__ void xcd_barrier(const XcdBarrier& b, int tid) {
    asm volatile("s_waitcnt vmcnt(0)" ::: "memory");
    __syncthreads();
    if (tid == 0) {
        unsigned* bar = b.bar;
        __builtin_amdgcn_s_waitcnt(0);
        unsigned nloc = b.st[0], nx = b.st[1];
        if (nloc == 0u) { xcd_barrier_complete(bar, b.x, nloc, nx); b.st[0] = nloc; b.st[1] = nx; }
        const unsigned old = xb_add(&bar[XB_XSUB(b.x)], 1u);
        const unsigned gen = old / nloc;
        if (old + 1u == (gen + 1u) * nloc) {
            __builtin_amdgcn_fence(__ATOMIC_RELEASE, "agent");
            asm volatile("s_waitcnt vmcnt(0)" ::: "memory");
            const unsigned og = xb_add(&bar[XB_TOP], 1u);
            const unsigned tg = og / nx;
            if (og + 1u == (tg + 1u) * nx) xb_add(&bar[XB_TOPGEN], 1u);
            else XB_SPIN(xb_ld(&bar[XB_TOPGEN]) == tg, bar);
            __builtin_amdgcn_fence(__ATOMIC_ACQUIRE, "agent");
        } else {
            XB_SPIN(xb_ld(&bar[XB_TOPGEN]) == gen, bar);
            __builtin_amdgcn_fence(__ATOMIC_ACQUIRE, "agent");
            asm volatile("s_waitcnt vmcnt(0)" ::: "memory");
        }
    }
    __syncthreads();
}

__device__ __forceinline__ void tail_signal(unsigned* ctr, int tid) {
    asm volatile("s_waitcnt vmcnt(0)" ::: "memory");
    __syncthreads();
    if (tid == 0) { __builtin_amdgcn_fence(__ATOMIC_RELEASE, "agent"); asm volatile("s_waitcnt vmcnt(0)" ::: "memory"); (void)xb_add(ctr, 1u); }
}
__device__ __forceinline__ void tail_wait(unsigned* ctr, unsigned n, unsigned* bar, int tid) {
    if (tid == 0) { XB_SPIN(xb_ld(ctr) < n, bar); __builtin_amdgcn_fence(__ATOMIC_ACQUIRE, "agent"); asm volatile("s_waitcnt vmcnt(0)" ::: "memory"); }
    __syncthreads();
}
namespace pg8 {
constexpr int BM = 256, BK = 64, HALF = 128, HTB = HALF * BK * 2, STAGE_BYTES = 8 * HTB, IDX_OFF = STAGE_BYTES + 1024;
__host__ __device__ __forceinline__ int lds_byte(int r, int c) { const int st = (r >> 4) * 2 + (c >> 5), rr = r & 15, cc = c & 31, ob = rr * 64 + cc * 2; return st * 1024 + (ob ^ (((ob >> 9) & 1) << 5)); }
__host__ __device__ __forceinline__ void stage_rc(int b, int& R, int& C) { const int st = b / 1024, sb = b % 1024, swz = sb ^ (((sb >> 9) & 1) << 5); R = (st >> 1) * 16 + swz / 64; C = (st & 1) * 32 + (swz % 64) / 2; }

struct Unit { int pm, pn, kind, tag; int aoff, boff; int nt, part; };
struct Gemm { const bf16_t* A0; const bf16_t* A1; const bf16_t* B0; const bf16_t* B1; int lda, ldb, K; const int* rowtab; float* part; int scaleB, scaleA; int lda1; };

template <class Epi, class Sched, bool GATHER = false, bool HALFB = false, bool FP8 = false, bool MIX = false>
__device__ __forceinline__ void gemm_phase(LAS unsigned char* lds, const Gemm g, const Sched& S, const Epi& E, int tid_in) {
    int tid = tid_in; asm volatile("" : "+v"(tid));
    const int wid = __builtin_amdgcn_readfirstlane(tid >> 6), lane = tid & 63, wr = wid >> 2, wc = wid & 3, fr = lane & 15, fq = lane >> 4;
    unsigned voffA[2], voffB[2], voffA1[2]; int Rg[2]; unsigned Cg2[2];
#pragma unroll
    for (int i = 0; i < 2; ++i) { int R, C; stage_rc(tid * 16 + i * 8192, R, C); voffA[i] = (unsigned)(R * g.lda + C) * 2u; voffB[i] = (unsigned)(R * g.ldb + C) * 2u; voffA1[i] = (unsigned)(R * g.lda1 + C) * 2u; Rg[i] = R; Cg2[i] = (unsigned)C * 2u; }
    unsigned vA[2][2];
#define PG8_GOFF(dst, u) do { _Pragma("unroll") for (int _h = 0; _h < 2; ++_h) _Pragma("unroll") for (int _i = 0; _i < 2; ++_i) \
        dst[_h][_i] = (unsigned)g.rowtab[(u).pm * BM + _h * HALF + Rg[_i]] * (unsigned)(g.lda * 2) + Cg2[_i]; } while (0)
    const size_t kstep = (size_t)(BK * 2);
    const size_t hstepA = (size_t)HALF * g.lda * 2, hstepB = (size_t)HALF * g.ldb * 2, hstepA1 = (size_t)HALF * g.lda1 * 2;
    const unsigned ldsw = (unsigned)wid * 1024u;
    const int aoff = lds_byte(wr * 64 + fr, fq * 8), boff = lds_byte(wc * 32 + fr, fq * 8);
#define PG8_SA(b, h) (((b) * 2 + (h)) * HTB)
#define PG8_SB(b, h) ((4 + (b) * 2 + (h)) * HTB)
#define PG8_STAGE(bufoff, gbase, voff) do { _Pragma("unroll") for (int _i = 0; _i < 2; ++_i) \
        __builtin_amdgcn_global_load_lds((const unsigned*)((const char*)(gbase) + (voff)[_i]), (LAS unsigned*)(lds + (bufoff) + ldsw + _i * 8192), 16, 0, 0); } while (0)
#define PG8_STAGE_A(bufoff, gbase, h, nx) do { if constexpr (GATHER) { PG8_STAGE(bufoff, gbase, vA[h]); } \
        else if constexpr (MIX) { const int _k1 = (nx) ? kn : kc; unsigned _v[2]; _v[0] = _k1 ? voffA1[0] : voffA[0]; _v[1] = _k1 ? voffA1[1] : voffA[1]; PG8_STAGE(bufoff, (gbase) + (h) * (_k1 ? hstepA1 : hstepA), _v); } \
        else { PG8_STAGE(bufoff, (gbase) + (h) * hstepA, voffA); } } while (0)
#define PG8_LDA(dst, b, h) do { _Pragma("unroll") for (int m = 0; m < 4; ++m) { dst[m].lo = *(const LAS bf16x8*)(lds + PG8_SA(b, h) + aoff + m * 2048); dst[m].hi = *(const LAS bf16x8*)(lds + PG8_SA(b, h) + aoff + m * 2048 + 1024); } } while (0)
#define PG8_LDB(dst, b, h) do { _Pragma("unroll") for (int n = 0; n < 2; ++n) { dst[n].lo = *(const LAS bf16x8*)(lds + PG8_SB(b, h) + boff + n * 2048); dst[n].hi = *(const LAS bf16x8*)(lds + PG8_SB(b, h) + boff + n * 2048 + 1024); } } while (0)
#define PG8_CAT(f) __builtin_bit_cast(v8i_t, (f))
#define PG8_MMA(ai, bj, At, Bt) do { __builtin_amdgcn_s_setprio(1); if constexpr (F8) { _Pragma("unroll") for (int m = 0; m < 4; ++m) _Pragma("unroll") for (int n = 0; n < 2; ++n) \
        asm volatile("v_mfma_scale_f32_16x16x128_f8f6f4 %0, %1, %2, %0, %3, %4 op_sel_hi:[0,0,0]" : "+v"(acc[ai][bj][m][n]) : "v"(PG8_CAT(Bt[n])), "v"(PG8_CAT(At[m])), "v"(vscB), "v"(vscA)); } \
    else if constexpr (MIX) { _Pragma("unroll") for (int m = 0; m < 4; ++m) _Pragma("unroll") for (int n = 0; n < 2; ++n) { \
        asm volatile("v_mfma_f32_16x16x32_bf16 %0, %1, %2, %0" : "+v"(acc[ai][bj][m][n]) : "v"(Bt[n].lo), "v"(At[m].lo)); asm volatile("v_mfma_f32_16x16x32_bf16 %0, %1, %2, %0" : "+v"(acc[ai][bj][m][n]) : "v"(Bt[n].hi), "v"(At[m].hi)); } } \
    else { _Pragma("unroll") for (int m = 0; m < 4; ++m) _Pragma("unroll") for (int n = 0; n < 2; ++n) _Pragma("unroll") for (int k = 0; k < 2; ++k) \
        acc[ai][bj][m][n] = __builtin_amdgcn_mfma_f32_16x16x32_bf16(k ? Bt[n].hi : Bt[n].lo, k ? At[m].hi : At[m].lo, acc[ai][bj][m][n], 0, 0, 0); } __builtin_amdgcn_s_setprio(0); } while (0)
#define PG8_WAIT_V(n) asm volatile("s_waitcnt vmcnt(" #n ")" ::: "memory")
#define PG8_WAIT_VK do { if constexpr (HALFB) asm volatile("s_waitcnt vmcnt(6)" ::: "memory"); else asm volatile("s_waitcnt vmcnt(8)" ::: "memory"); } while (0)
#define PG8_WAIT_VK1 do { if (Epi::NST > 0 && t == 0 && ui > 0) asm volatile("s_waitcnt vmcnt(%0)" :: "n"((HALFB ? 6 : 8) + Epi::NST) : "memory"); else PG8_WAIT_VK; } while (0)
#define PG8_STAGE_B1(bufoff, gbase) do { if constexpr (!HALFB) PG8_STAGE(bufoff, gbase, voffB); } while (0)
#define PG8_LDB1(dst, b, h) do { if constexpr (!HALFB) PG8_LDB(dst, b, h); } while (0)
#define PG8_MMA1(ai, bj, At, Bt) do { if constexpr (!HALFB) PG8_MMA(ai, bj, At, Bt); } while (0)
#define PG8_WAIT_L(n) asm volatile("s_waitcnt lgkmcnt(" #n ")" ::: "memory")
#define PG8_BAR __builtin_amdgcn_s_barrier()
#define PG8_SCHED __builtin_amdgcn_sched_barrier(0)
#define PG8_ABASE(u) ((const char*)((u).kind ? g.A1 : g.A0) + ((size_t)(u).aoff + (GATHER ? (size_t)0 : (size_t)(u).pm * BM * ((MIX && (u).kind) ? g.lda1 : g.lda))) * 2)
#define PG8_BBASE(u) ((const char*)((u).kind ? g.B1 : g.B0) + ((size_t)(u).boff + (size_t)(u).pn * (HALFB ? HALF : BM) * g.ldb) * 2)
    int vscA = g.scaleA, vscB = g.scaleB; (void)vscA; (void)vscB;
    Unit cur, nxt; int ui = 0;
    if (!S.next(0, cur)) return;
    f32x4 acc[2][2][4][2];
#pragma unroll
    for (int a = 0; a < 2; ++a)
#pragma unroll
        for (int b = 0; b < 2; ++b)
#pragma unroll
            for (int m = 0; m < 4; ++m)
#pragma unroll
                for (int n = 0; n < 2; ++n) acc[a][b][m][n] = (f32x4){0.f, 0.f, 0.f, 0.f};
    bf16x16 At[4], B0[2], B1[2];
    const char* cA = PG8_ABASE(cur); const char* cB = PG8_BBASE(cur);
    int kc = cur.kind, kn = cur.kind; (void)kc; (void)kn;
    if constexpr (GATHER) { PG8_GOFF(vA, cur); }
    PG8_STAGE(PG8_SB(0, 0), cB, voffB); PG8_STAGE_B1(PG8_SB(0, 1), cB + hstepB); PG8_STAGE_A(PG8_SA(0, 0), cA, 0, false); PG8_STAGE_A(PG8_SA(0, 1), cA, 1, false);
    if (wr == 1) PG8_BAR;
    PG8_WAIT_V(2); PG8_BAR;
    PG8_STAGE(PG8_SB(1, 0), cB + kstep, voffB); PG8_STAGE_A(PG8_SA(1, 0), cA + kstep, 0, false); PG8_STAGE_B1(PG8_SB(1, 1), cB + hstepB + kstep);
    if constexpr (HALFB) PG8_WAIT_V(4); else PG8_WAIT_V(6);
    PG8_BAR;
    for (;;) {
        const bool has_next = S.next(ui + 1, nxt);
        const char* nA = has_next ? PG8_ABASE(nxt) : cA; const char* nB = has_next ? PG8_BBASE(nxt) : cB;
        if constexpr (GATHER) { if (has_next) {
            _Pragma("unroll") for (int _h = 0; _h < 2; ++_h) _Pragma("unroll") for (int _i = 0; _i < 2; ++_i)
                __builtin_amdgcn_global_load_lds((const unsigned*)(g.rowtab + nxt.pm * BM + _h * HALF + Rg[_i]), (LAS unsigned*)(lds + IDX_OFF + ((_h * 2 + _i) * 8 + wid) * 256), 4, 0, 0); } }
        const int nt = cur.nt;
#define PG8_TLOOP \
        _Pragma("unroll 1") for (int t = 0; t < nt; t += 2) { \
            const bool last = (t == nt - 2); \
            kc = cur.kind; kn = (last && has_next) ? nxt.kind : cur.kind; \
            const char* a1 = cA + (size_t)(t + 1) * kstep; \
            const char* a2 = last ? nA : cA + (size_t)(t + 2) * kstep; const char* b2 = last ? nB : cB + (size_t)(t + 2) * kstep; \
            const char* a3 = a2 + kstep; const char* b3 = b2 + kstep; \
 \
            PG8_LDB(B0, 0, 0); PG8_LDB1(B1, 0, 1); PG8_SCHED; PG8_LDA(At, 0, 0); PG8_STAGE_A(PG8_SA(1, 1), a1, 1, false); \
            if constexpr (GATHER) { if (last && has_next) { \
                _Pragma("unroll") for (int _h = 0; _h < 2; ++_h) _Pragma("unroll") for (int _i = 0; _i < 2; ++_i) \
                    vA[_h][_i] = *(const LAS unsigned*)(lds + IDX_OFF + ((_h * 2 + _i) * 8 + wid) * 256 + lane * 4) * (unsigned)(g.lda * 2) + Cg2[_i]; } } \
            PG8_WAIT_VK1; PG8_WAIT_L(0); PG8_BAR; PG8_MMA(0, 0, At, B0); PG8_MMA1(0, 1, At, B1); PG8_BAR; PG8_SCHED; \
            PG8_LDA(At, 0, 1); PG8_STAGE(PG8_SB(0, 0), b2, voffB); PG8_STAGE_B1(PG8_SB(0, 1), b2 + hstepB); PG8_STAGE_A(PG8_SA(0, 0), a2, 0, last); \
            PG8_WAIT_VK1; PG8_WAIT_L(0); PG8_BAR; PG8_MMA(1, 0, At, B0); PG8_MMA1(1, 1, At, B1); PG8_BAR; PG8_SCHED; \
            PG8_LDB(B0, 1, 0); PG8_LDB1(B1, 1, 1); PG8_SCHED; PG8_LDA(At, 1, 0); PG8_STAGE_A(PG8_SA(0, 1), a2, 1, last); \
            PG8_WAIT_VK; PG8_WAIT_L(0); PG8_BAR; PG8_MMA(0, 0, At, B0); PG8_MMA1(0, 1, At, B1); PG8_BAR; PG8_SCHED; \
            PG8_LDA(At, 1, 1); PG8_STAGE(PG8_SB(1, 0), b3, voffB); PG8_STAGE_B1(PG8_SB(1, 1), b3 + hstepB); PG8_STAGE_A(PG8_SA(1, 0), a3, 0, last); \
            PG8_WAIT_VK; PG8_WAIT_L(0); PG8_BAR; PG8_MMA(1, 0, At, B0); PG8_MMA1(1, 1, At, B1); PG8_BAR; PG8_SCHED; \
        } \

        if constexpr (MIX) { if (cur.kind == 0) { constexpr bool F8 = true; PG8_TLOOP } else { constexpr bool F8 = false; PG8_TLOOP } }
        else { constexpr bool F8 = FP8; PG8_TLOOP }
#undef PG8_TLOOP
        if (wr == 0) PG8_BAR;
        if constexpr (FP8 || MIX) asm volatile("s_nop 15\n\ts_nop 15\n\ts_nop 15\n\ts_nop 15" ::: "memory");
        E(acc, cur, wr, wc, fr, fq);
        if (!has_next) break;
#pragma unroll
        for (int a = 0; a < 2; ++a)
#pragma unroll
            for (int b = 0; b < 2; ++b)
#pragma unroll
                for (int m = 0; m < 4; ++m)
#pragma unroll
                    for (int n = 0; n < 2; ++n) acc[a][b][m][n] = (f32x4){0.f, 0.f, 0.f, 0.f};
        cur = nxt; cA = nA; cB = nB; ++ui;
        if (wr == 1) PG8_BAR;
    }
    PG8_WAIT_V(0);
    PG8_BAR;
#undef PG8_SA
#undef PG8_SB
#undef PG8_STAGE
#undef PG8_STAGE_A
#undef PG8_GOFF
#undef PG8_LDA
#undef PG8_LDB
#undef PG8_MMA
#undef PG8_CAT
#undef PG8_WAIT_V
#undef PG8_WAIT_VK
#undef PG8_WAIT_VK1
#undef PG8_STAGE_B1
#undef PG8_LDB1
#undef PG8_MMA1
#undef PG8_WAIT_L
#undef PG8_BAR
#undef PG8_SCHED
#undef PG8_ABASE
#undef PG8_BBASE
}
}
struct Args { const float* in[N_IN]; float* out; unsigned char* ws; int ph_lo, ph_hi; };
typedef const __attribute__((address_space(4))) Args* KArgs;

using pg8::Unit;
typedef f32x4 Acc[2][2][4][2];

__device__ __forceinline__ void blk8(int L, int nM, int nN, int& pm, int& pn) {
    const int per = nM * 8; int cb = L / per; const int nfull = nN >> 3; if (cb > nfull) cb = nfull; const int rem = L - cb * per; const int w = (cb < nfull) ? 8 : (nN - 8 * nfull);
    pm = rem / w; pn = 8 * cb + rem % w;
}
struct Sched2D {
    int nM, nN, G, c; int aoff, boff; int ntk; int rot; int pm0 = 0;
    __device__ __forceinline__ int count() const { return nM * nN; }
    __device__ __forceinline__ void unit(int L, Unit& u) const { u.pm = L / nN; u.pn = L % nN; u.kind = 0; u.tag = 0; u.aoff = aoff; u.boff = boff; u.nt = ntk; u.part = -1; }
    __device__ __forceinline__ bool next(int i, Unit& u) const { const int L = i * G + c; if (L >= nM * nN) return false; unit(L, u); if (rot == 1) u.pn = (u.pn + i) % nN;
        if (rot == 2) blk8(L, nM, nN, u.pm, u.pn); u.pm += pm0; return true; }
};
struct SchedS5 {
    int nN, G, c; int astride, bstride; int ntk;
    __device__ __forceinline__ bool next(int i, Unit& u) const {
        const int L = i * G + c; const int per = 5 * nN; if (L >= 16 * per) return false;
        const int g = L / per, r = L % per; u.pm = r / nN; u.pn = r % nN; u.kind = 0; u.tag = g; u.aoff = g * astride; u.boff = g * bstride; u.nt = ntk; u.part = -1; return true;
    }
};
struct SchedMerge {
    int t0, t1, G, c;
    __device__ __forceinline__ bool next(int i, Unit& u) const {
        const int T = t0 + (i >> 3) * G + c; if (T >= t1) return false;
        const int gate = (i >> 1) & 3;
        u.pm = T >> 3; u.pn = T & 7; u.kind = i & 1; u.tag = gate; u.aoff = (i & 1) ? gate * 256 : 0; u.boff = gate * 1024 * 512; u.nt = (i & 1) ? 4 : 8; u.part = -1; return true;
    }
};
struct SchedMoe {
    const LAS int* base; int nN, G, c; int bstride; int ntk;
    __device__ __forceinline__ int count() const { return (base[8] >> 8) * nN; }
    __device__ __forceinline__ void unit(int L, Unit& u) const {
        int t, pn_; blk8(L, base[8] >> 8, nN, t, pn_); const int row = t * 256; int e = 0;
#pragma unroll
        for (int k = 1; k < 8; ++k) e += (row >= base[k]) ? 1 : 0;
        u.pm = t; u.pn = pn_; u.kind = 0; u.tag = e; u.aoff = 0; u.boff = e * bstride; u.nt = ntk; u.part = -1;
    }
    __device__ __forceinline__ bool next(int i, Unit& u) const { const int L = i * G + c; if (L >= count()) return false; unit(L, u); return true; }
};
template <class Base> struct SplitTail {
    Base B; int U, G, c, ntk, full, R, s;
    __device__ __forceinline__ void init(const Base& b, int G_, int c_, int ntk_) { B = b; G = G_; c = c_; ntk = ntk_; U = b.count(); full = (U / G) * G; R = U - full; s = 1;
        if (R > 0) { int smax = G / R; if (smax > ntk / 2) smax = ntk / 2; for (int k = smax; k > 1; --k) if ((ntk / 2) % k == 0) { s = k; break; } } }
    __device__ __forceinline__ bool next(int i, Unit& u) const {
        const int L = i * G + c;
        if (L < full || s == 1) { if (L >= U) return false; B.unit(L, u); return true; }
        if (i != full / G || c >= R * s) return false;
        const int t = c / s, p = c - t * s, kt = ntk / s; B.unit(full + t, u); u.aoff += p * kt * 64; u.boff += p * kt * 64; u.nt = kt; u.part = c; return true;
    }
};
template <class Epi, class Base>
__device__ __forceinline__ void gemm_fixup(const SplitTail<Base>& S, const Epi& E, const float* part, int bx) {
    if (S.s == 1) return;
    int tid = threadIdx.x; asm volatile("" : "+v"(tid));
    const int wid = __builtin_amdgcn_readfirstlane(tid >> 6), lane = tid & 63, wr = wid >> 2, wc = wid & 3, fr = lane & 15, fq = lane >> 4;
    for (int t = bx; t < S.R; t += S.G) {
        Unit u; S.B.unit(S.full + t, u);
        f32x4 acc[2][2][4][2];
#pragma unroll
        for (int a = 0; a < 2; ++a)
#pragma unroll
            for (int b = 0; b < 2; ++b)
#pragma unroll
                for (int m = 0; m < 4; ++m)
#pragma unroll
                    for (int n = 0; n < 2; ++n) acc[a][b][m][n] = (f32x4){0.f, 0.f, 0.f, 0.f};
        for (int p = 0; p < S.s; ++p) {
            const f32x4* pp = (const f32x4*)(part + (size_t)(t * S.s + p) * 65536) + tid;
#pragma unroll
            for (int a = 0; a < 2; ++a)
#pragma unroll
                for (int b = 0; b < 2; ++b)
#pragma unroll
                    for (int m = 0; m < 4; ++m)
#pragma unroll
                        for (int n = 0; n < 2; ++n) { acc[a][b][m][n] += *pp; pp += 512; asm volatile("" : "+v"(pp) :: "memory"); }
        }
        E(acc, u, wr, wc, fr, fq);
    }
}

#define EPI_ROW(u, ai, m) ((u).pm * 256 + (ai) * 128 + wr * 64 + (m) * 16 + fr)
#define EPI_COL(bj, n) ((bj) * 128 + wc * 32 + (n) * 16 + 4 * fq)

struct EpiPlain {
    static constexpr int NST = 16;
    bf16_t* O; int ldc; int mrows;
    __device__ __forceinline__ void operator()(const Acc& acc, const Unit& u, int wr, int wc, int fr, int fq) const {
#pragma unroll
        for (int ai = 0; ai < 2; ++ai)
#pragma unroll
            for (int m = 0; m < 4; ++m) { const int row = EPI_ROW(u, ai, m); if (row < mrows) { bf16_t* rp = O + (size_t)row * ldc + u.pn * 256 + wc * 32 + 8 * fq;
#pragma unroll
                for (int bj = 0; bj < 2; ++bj) { const f32x4 v0 = acc[ai][bj][m][0], v1 = acc[ai][bj][m][1]; u32x4 w; w.x = pk2(v0[0], v0[1]); w.y = pk2(v0[2], v0[3]); w.z = pk2(v1[0], v1[1]); w.w = pk2(v1[2], v1[3]);
                    *(u32x4*)(rp + bj * 128) = w; } } }
    }
};
struct EpiSwiglu {
    static constexpr int NST = 8;
    bf16_t* H; int ldh;
    __device__ __forceinline__ void operator()(const Acc& acc, const Unit& u, int wr, int wc, int fr, int fq) const {
#pragma unroll
        for (int ai = 0; ai < 2; ++ai)
#pragma unroll
            for (int m = 0; m < 4; ++m) { bf16_t* rp = H + (size_t)EPI_ROW(u, ai, m) * ldh + u.pn * 128 + wc * 32 + 8 * fq; float o[8];
#pragma unroll
                for (int bj = 0; bj < 2; ++bj) { const f32x4 a = acc[ai][bj][m][0], b = acc[ai][bj][m][1];
                    const f32x4 t = a * (-LOG2E); f32x4 ex; ex[0] = fast_exp2(t[0]); ex[1] = fast_exp2(t[1]); ex[2] = fast_exp2(t[2]); ex[3] = fast_exp2(t[3]);
                    const f32x4 dn = ex + 1.0f; f32x4 rc; rc[0] = rcp_(dn[0]); rc[1] = rcp_(dn[1]); rc[2] = rcp_(dn[2]); rc[3] = rcp_(dn[3]);
                    const f32x4 ov = (a * b) * rc; o[4 * bj] = ov[0]; o[4 * bj + 1] = ov[1]; o[4 * bj + 2] = ov[2]; o[4 * bj + 3] = ov[3]; }
                u32x4 w; w.x = pk2(o[0], o[1]); w.y = pk2(o[2], o[3]); w.z = pk2(o[4], o[5]); w.w = pk2(o[6], o[7]); *(u32x4*)rp = w; asm volatile("" ::: "memory"); }
    }
};
struct EpiSwiglu8 {
    static constexpr int NST = 8;
    unsigned char* H; int ldh;
    __device__ __forceinline__ void operator()(const Acc& acc, const Unit& u, int wr, int wc, int fr, int fq) const {
#pragma unroll
        for (int ai = 0; ai < 2; ++ai)
#pragma unroll
            for (int m = 0; m < 4; ++m) { unsigned char* rp = H + (size_t)EPI_ROW(u, ai, m) * ldh + u.pn * 128 + wc * 32 + 8 * fq; u32x2 w;
#pragma unroll
                for (int bj = 0; bj < 2; ++bj) { const f32x4 a = acc[ai][bj][m][0], b = acc[ai][bj][m][1];
                    const f32x4 t = a * (-LOG2E); f32x4 ex; ex[0] = fast_exp2(t[0]); ex[1] = fast_exp2(t[1]); ex[2] = fast_exp2(t[2]); ex[3] = fast_exp2(t[3]);
                    const f32x4 dn = ex * 0.125f + 0.125f; f32x4 rc; rc[0] = rcp_(dn[0]); rc[1] = rcp_(dn[1]); rc[2] = rcp_(dn[2]); rc[3] = rcp_(dn[3]);
                    const f32x4 o = (a * b) * rc;
                    const unsigned pk = pk4_fp8(o[0], o[1], o[2], o[3]); if (bj == 0) w.x = pk; else w.y = pk; asm volatile("" : "+v"(w)); }
                *(u32x2*)rp = w; asm volatile("" ::: "memory"); }
    }
};
struct EpiZ {
    static constexpr int NST = 16;
    bf16_t* Z; bf16_t* VTL; bf16_t* VTC; bf16_t* AS5; const float* ropec; const float* ropes;
    __device__ __forceinline__ void operator()(const Acc& acc, const Unit& u, int wr, int wc, int fr, int fq) const {
        const int pn = u.pn; const bool latent = u.pm < 128;
#pragma unroll
        for (int ai = 0; ai < 2; ++ai)
#pragma unroll
            for (int m = 0; m < 4; ++m) {
                const int row = EPI_ROW(u, ai, m);
                if (pn <= 4 || pn == 5) {
#pragma unroll
                    for (int bj = 0; bj < 2; ++bj) {
                        if (pn == 5 && bj == 1) continue;
                        f32x4 v0 = acc[ai][bj][m][0], v1 = acc[ai][bj][m][1];
                        if ((pn == 2 || pn == 5) && latent) {
                            const int t = row & (SEQ - 1); const int pos = (wc & 1) ? (t & 63) : (t >> 6);
                            const f32x4 cs = *(const f32x4*)(ropec + pos * 16 + 4 * fq), sn = *(const f32x4*)(ropes + pos * 16 + 4 * fq);
                            const f32x4 r0 = v0 * cs - v1 * sn, r1 = v0 * sn + v1 * cs; v0 = r0; v1 = r1;
                        }
                        if (pn == 3 || pn == 4) { bf16_t* rp = Z + (size_t)row * ZC + pn * 256 + bj * 128 + wc * 32 + 4 * fq;
                            u32x2 w; w.x = pk2(v0[0], v0[1]); w.y = pk2(v0[2], v0[3]); *(u32x2*)(rp) = w;
                            w.x = pk2(v1[0], v1[1]); w.y = pk2(v1[2], v1[3]); *(u32x2*)(rp + 16) = w; }
                        else {
                            bf16_t* rp = Z + (size_t)row * ZC + (pn < 5 ? pn * 256 : ZKD) + bj * 128 + wc * 32 + 8 * fq;
                            u32x4 w; w.x = pk2(v0[0], v0[1]); w.y = pk2(v0[2], v0[3]); w.z = pk2(v1[0], v1[1]); w.w = pk2(v1[2], v1[3]); *(u32x4*)(rp) = w; }
                    }
                }
                if (pn == 5 || pn == 6) {
                    const int qi = fr & 3; const unsigned sel1 = (qi & 1) ? 0x03020706u : 0x05040100u; const bool hi2 = (qi & 2) != 0;
#pragma unroll
                    for (int bj = 0; bj < 2; ++bj) {
                        if (pn == 5 && bj == 0) continue;
#pragma unroll
                        for (int n = 0; n < 2; ++n) {
                            const int tc = bj * 128 + wc * 32 + n * 16 + 4 * fq;
                            const int hv = (pn == 6) ? (tc >> 6) : 4 + ((tc - 128) >> 6); const int d0 = tc & 63;
                            const f32x4 v = acc[ai][bj][m][n];
                            const unsigned p01 = pk2(v[0], v[1]), p23 = pk2(v[2], v[3]);
                            const unsigned r01 = (unsigned)__builtin_amdgcn_update_dpp(0, (int)p01, 0xB1, 0xF, 0xF, true), r23 = (unsigned)__builtin_amdgcn_update_dpp(0, (int)p23, 0xB1, 0xF, 0xF, true);
                            const unsigned qa = __builtin_amdgcn_perm(r01, p01, sel1), qb = __builtin_amdgcn_perm(r23, p23, sel1);
                            const unsigned snd = hi2 ? qa : qb; const unsigned rcv = (unsigned)__builtin_amdgcn_update_dpp(0, (int)snd, 0x4E, 0xF, 0xF, true);
                            u32x2 w; w.x = hi2 ? rcv : qa; w.y = hi2 ? qb : rcv;
                            if (latent) { const int b = row >> 13, t = (row & (SEQ - 1)) & ~3; *(u32x2*)(VTL + ((size_t)((b * 6 + hv) * 64 + d0 + qi)) * SEQ + t) = w; }
                            else { const int rc = row - NLAT, b = rc >> 8, l = (rc & 255) & ~3; *(u32x2*)(VTC + ((size_t)((b * 6 + hv) * 64 + d0 + qi)) * CTXL + l) = w; }
                        }
                    }
                }
                if (pn == 7) {
                    const int cr = row >> 5, i = row & 31;
#pragma unroll
                    for (int bj = 0; bj < 2; ++bj)
#pragma unroll
                        for (int n = 0; n < 2; ++n) { const int g = bj * 8 + wc * 2 + n; const f32x4 v = acc[ai][bj][m][n];
                            u32x2 w; w.x = pk2(v[0], v[1]); w.y = pk2(v[2], v[3]); *(u32x2*)(AS5 + ((size_t)g * S5M + cr) * 768 + i * 16 + 4 * fq) = w; }
                }
            }
    }
};
struct EpiSloc {
    static constexpr int NST = 0;
    float* SLOC;
    __device__ __forceinline__ void operator()(const Acc& acc, const Unit& u, int wr, int wc, int fr, int fq) const {
#pragma unroll
        for (int ai = 0; ai < 2; ++ai)
#pragma unroll
            for (int m = 0; m < 4; ++m) { const int cr = EPI_ROW(u, ai, m); if (cr < S5CH) { float* rp = SLOC + ((size_t)cr * 16 + u.tag) * 256;
#pragma unroll
                for (int bj = 0; bj < 2; ++bj)
#pragma unroll
                    for (int n = 0; n < 2; ++n) *(f32x4*)(rp + EPI_COL(bj, n)) = acc[ai][bj][m][n]; } }
    }
};
struct EpiY {
    static constexpr int NST = 0;
    bf16_t* YS5;
    __device__ __forceinline__ void operator()(const Acc& acc, const Unit& u, int wr, int wc, int fr, int fq) const {
#pragma unroll
        for (int ai = 0; ai < 2; ++ai)
#pragma unroll
            for (int m = 0; m < 4; ++m) { const int cr = EPI_ROW(u, ai, m); if (cr < S5CH) {
#pragma unroll
                for (int bj = 0; bj < 2; ++bj)
#pragma unroll
                    for (int n = 0; n < 2; ++n) { const int j = u.pn * 16 + bj * 8 + wc * 2 + n; const f32x4 v = acc[ai][bj][m][n];
                        u32x2 w; w.x = pk2(geluf_(v[0]), geluf_(v[1])); w.y = pk2(geluf_(v[2]), geluf_(v[3]));
                        *(u32x2*)(YS5 + ((size_t)cr * 32 + j) * 256 + u.tag * 16 + 4 * fq) = w; } } }
    }
};
struct EpiGlu {
    static constexpr int NST = 0;
    const bf16_t* YS5; const float* glub; bf16_t* O;
    __device__ __forceinline__ void operator()(const Acc& acc, const Unit& u, int wr, int wc, int fr, int fq) const {
#pragma unroll
        for (int ai = 0; ai < 2; ++ai)
#pragma unroll
            for (int m = 0; m < 4; ++m) { const int row = EPI_ROW(u, ai, m);
#pragma unroll
                for (int bj = 0; bj < 2; ++bj)
#pragma unroll
                    for (int n = 0; n < 2; ++n) { const int col = EPI_COL(bj, n); const f32x4 v = acc[ai][bj][m][n]; const f32x4 bb = *(const f32x4*)(glub + col);
                        const u32x2 yw = *(const u32x2*)(YS5 + (size_t)row * 256 + col);
                        const float y0 = bflo(yw.x), y1 = bfhi(yw.x), y2 = bflo(yw.y), y3 = bfhi(yw.y);
                        u32x2 w; w.x = pk2(y0 * sigmoidf_(v[0] + bb[0]), y1 * sigmoidf_(v[1] + bb[1])); w.y = pk2(y2 * sigmoidf_(v[2] + bb[2]), y3 * sigmoidf_(v[3] + bb[3]));
                        *(u32x2*)(O + (size_t)row * 1024 + 512 + col) = w; }
                if (m & 1) asm volatile("" ::: "memory"); }
    }
};
struct EpiMerge {
    static constexpr int NST = 0;
    bf16_t* outp; mutable u32x2 S[2][4][2]; mutable u32x2 M[2][4][2];
    __device__ __forceinline__ void operator()(const Acc& acc, const Unit& u, int wr, int wc, int fr, int fq) const {
        if (u.kind == 0) {
#pragma unroll
            for (int ai = 0; ai < 2; ++ai)
#pragma unroll
                for (int m = 0; m < 4; ++m)
#pragma unroll
                    for (int n = 0; n < 2; ++n) { const f32x4 a = acc[ai][0][m][n]; S[ai][m][n] = (u32x2){pk2(sigmoidf_(a[0]), sigmoidf_(a[1])), pk2(sigmoidf_(a[2]), sigmoidf_(a[3]))}; }
        } else {
            const int gate = u.tag;
#pragma unroll
            for (int ai = 0; ai < 2; ++ai)
#pragma unroll
                for (int m = 0; m < 4; ++m)
#pragma unroll
                    for (int n = 0; n < 2; ++n) { const u32x2 w = S[ai][m][n]; const f32x4 a = acc[ai][0][m][n]; const u32x2 mo = M[ai][m][n];
                        f32x4 r = (f32x4){bflo(w.x) * a[0], bfhi(w.x) * a[1], bflo(w.y) * a[2], bfhi(w.y) * a[3]};
                        if (gate > 0) r += (f32x4){bflo(mo.x), bfhi(mo.x), bflo(mo.y), bfhi(mo.y)};
                        const u32x2 o = (u32x2){pk2(r[0], r[1]), pk2(r[2], r[3])}; M[ai][m][n] = o;
                        if (gate == 3) *(u32x2*)(outp + (size_t)EPI_ROW(u, ai, m) * 1024 + u.pn * 128 + wc * 32 + n * 16 + 4 * fq) = o; }
        }
    }
};
#define MFMA16(a, b, c) __builtin_amdgcn_mfma_f32_16x16x32_bf16((a), (b), (c), 0, 0, 0)
__device__ __forceinline__ float xmax_rows(float x) {
    { auto r = __builtin_amdgcn_permlane16_swap(__float_as_uint(x), __float_as_uint(x), false, false); x = __builtin_fmaxf(__uint_as_float(r[0]), __uint_as_float(r[1])); }
    { auto r = __builtin_amdgcn_permlane32_swap(__float_as_uint(x), __float_as_uint(x), false, false); x = __builtin_fmaxf(__uint_as_float(r[0]), __uint_as_float(r[1])); }
    return x; }
__device__ __forceinline__ float xsum_rows(float x) {
    { auto r = __builtin_amdgcn_permlane16_swap(__float_as_uint(x), __float_as_uint(x), false, false); x = __uint_as_float(r[0]) + __uint_as_float(r[1]); }
    { auto r = __builtin_amdgcn_permlane32_swap(__float_as_uint(x), __float_as_uint(x), false, false); x = __uint_as_float(r[0]) + __uint_as_float(r[1]); }
    return x; }
constexpr float ATT_THR2 = 11.5f;
template <int NH> struct AttnState { bf16x8 q[NH][2]; f32x4 o[NH][4]; float m[NH], l[NH]; };

template <int NH> __device__ __forceinline__ void attn_init(AttnState<NH>& st) {
#pragma unroll
    for (int h = 0; h < NH; ++h) { st.m[h] = -INFINITY; st.l[h] = 0.f;
#pragma unroll
        for (int d = 0; d < 4; ++d) st.o[h][d] = (f32x4){0.f, 0.f, 0.f, 0.f}; }
}
struct AttnFrag { bf16x8 ka0, ka1, kb0, kb1; s16x4 vlo[4], vhi[4]; };
__device__ __forceinline__ void attn_load(AttnFrag& f, const bf16_t* kr0, const bf16_t* kr1, const bf16_t* vlo, const bf16_t* vhi, size_t dstride) {
    f.ka0 = *(const bf16x8*)(kr0); f.ka1 = *(const bf16x8*)(kr0 + 32); f.kb0 = *(const bf16x8*)(kr1); f.kb1 = *(const bf16x8*)(kr1 + 32);
#pragma unroll
    for (int d = 0; d < 4; ++d) { f.vlo[d] = *(const s16x4*)(vlo + d * dstride); f.vhi[d] = *(const s16x4*)(vhi + d * dstride); }
}
template <int NH, class BiasF>
__device__ __forceinline__ void attn_compute(AttnState<NH>& st, const AttnFrag& f, const BiasF& bias) {
    bf16x8 vf[4];
#pragma unroll
    for (int d = 0; d < 4; ++d) vf[d] = __builtin_shufflevector(f.vlo[d], f.vhi[d], 0, 1, 2, 3, 4, 5, 6, 7);
#pragma unroll
    for (int h = 0; h < NH; ++h) {
        const f32x4 z4 = (f32x4){0.f, 0.f, 0.f, 0.f};
        f32x4 s0 = MFMA16(f.ka0, st.q[h][0], z4); s0 = MFMA16(f.ka1, st.q[h][1], s0);
        f32x4 s1 = MFMA16(f.kb0, st.q[h][0], z4); s1 = MFMA16(f.kb1, st.q[h][1], s1);
        float x[8];
#pragma unroll
        for (int e = 0; e < 4; ++e) { x[e] = bias(h, 0, e, s0[e]); x[4 + e] = bias(h, 1, e, s1[e]); }
        float mx = fmaxf(fmaxf(fmaxf(x[0], x[1]), fmaxf(x[2], x[3])), fmaxf(fmaxf(x[4], x[5]), fmaxf(x[6], x[7])));
        mx = xmax_rows(mx);
        float mn = st.m[h];
        if (__ballot(mx > mn + ATT_THR2) != 0ull) {
            mn = fmaxf(mn, mx); const float alpha = fast_exp2(st.m[h] - mn); st.l[h] *= alpha; st.m[h] = mn;
#pragma unroll
            for (int d = 0; d < 4; ++d) st.o[h][d] = st.o[h][d] * alpha; }
        float p[8]; float ls = 0.f;
#pragma unroll
        for (int e = 0; e < 8; ++e) { p[e] = fast_exp2(x[e] - mn); ls += p[e]; }
        st.l[h] += xsum_rows(ls);
        u32x4 pw; pw.x = pk2(p[0], p[1]); pw.y = pk2(p[2], p[3]); pw.z = pk2(p[4], p[5]); pw.w = pk2(p[6], p[7]);
        const bf16x8 pf = __builtin_bit_cast(bf16x8, pw);
#pragma unroll
        for (int d = 0; d < 4; ++d) st.o[h][d] = MFMA16(vf[d], pf, st.o[h][d]);
    }
}
template <int NH, class B0, class B1>
__device__ __forceinline__ void attn_compute2(AttnState<NH>& st, const AttnFrag& f0, const B0& bias0, const AttnFrag& f1, const B1& bias1) {
    constexpr bool PL = B0::PLAIN && B1::PLAIN;
    bf16x8 v0[4], v1[4];
#pragma unroll
    for (int d = 0; d < 4; ++d) { v0[d] = __builtin_shufflevector(f0.vlo[d], f0.vhi[d], 0, 1, 2, 3, 4, 5, 6, 7); v1[d] = __builtin_shufflevector(f1.vlo[d], f1.vhi[d], 0, 1, 2, 3, 4, 5, 6, 7); }
#pragma unroll
    for (int h = 0; h < NH; ++h) {
        const f32x4 z4 = (f32x4){0.f, 0.f, 0.f, 0.f};
        f32x4 s00 = MFMA16(f0.ka0, st.q[h][0], z4); s00 = MFMA16(f0.ka1, st.q[h][1], s00);
        f32x4 s01 = MFMA16(f0.kb0, st.q[h][0], z4); s01 = MFMA16(f0.kb1, st.q[h][1], s01);
        f32x4 s10 = MFMA16(f1.ka0, st.q[h][0], z4); s10 = MFMA16(f1.ka1, st.q[h][1], s10);
        f32x4 s11 = MFMA16(f1.kb0, st.q[h][0], z4); s11 = MFMA16(f1.kb1, st.q[h][1], s11);
        float x[16];
#pragma unroll
        for (int e = 0; e < 4; ++e) { x[e] = PL ? s00[e] : bias0(h, 0, e, s00[e]); x[4 + e] = PL ? s01[e] : bias0(h, 1, e, s01[e]); x[8 + e] = PL ? s10[e] : bias1(h, 0, e, s10[e]); x[12 + e] = PL ? s11[e] : bias1(h, 1, e, s11[e]); }
        float mx = fmaxf(fmaxf(fmaxf(x[0], x[1]), fmaxf(x[2], x[3])), fmaxf(fmaxf(x[4], x[5]), fmaxf(x[6], x[7])));
        mx = fmaxf(mx, fmaxf(fmaxf(fmaxf(x[8], x[9]), fmaxf(x[10], x[11])), fmaxf(fmaxf(x[12], x[13]), fmaxf(x[14], x[15]))));
        mx = xmax_rows(mx); if (PL) mx *= SC2;
        float mn = st.m[h];
        if (__ballot(mx > mn + ATT_THR2) != 0ull) {
            mn = fmaxf(mn, mx); const float alpha = fast_exp2(st.m[h] - mn); st.l[h] *= alpha; st.m[h] = mn;
#pragma unroll
            for (int d = 0; d < 4; ++d) st.o[h][d] = st.o[h][d] * alpha; }
        float p[16]; float ls0 = 0.f, ls1 = 0.f;
#pragma unroll
        for (int e = 0; e < 8; ++e) { p[e] = fast_exp2(PL ? fmaf(x[e], SC2, -mn) : x[e] - mn); ls0 += p[e]; p[8 + e] = fast_exp2(PL ? fmaf(x[8 + e], SC2, -mn) : x[8 + e] - mn); ls1 += p[8 + e]; }
        st.l[h] += xsum_rows(ls0 + ls1);
        u32x4 pw; pw.x = pk2(p[0], p[1]); pw.y = pk2(p[2], p[3]); pw.z = pk2(p[4], p[5]); pw.w = pk2(p[6], p[7]);
        u32x4 pv; pv.x = pk2(p[8], p[9]); pv.y = pk2(p[10], p[11]); pv.z = pk2(p[12], p[13]); pv.w = pk2(p[14], p[15]);
        const bf16x8 pf0 = __builtin_bit_cast(bf16x8, pw), pf1 = __builtin_bit_cast(bf16x8, pv);
#pragma unroll
        for (int d = 0; d < 4; ++d) { st.o[h][d] = MFMA16(v0[d], pf0, st.o[h][d]); st.o[h][d] = MFMA16(v1[d], pf1, st.o[h][d]); }
    }
}
template <int NH> __device__ __forceinline__ void attn_store(const AttnState<NH>& st, bf16_t* O, int qrow, int col0, int quad) {
#pragma unroll
    for (int h = 0; h < NH; ++h) { const float inv = 1.0f / st.l[h];
#pragma unroll
        for (int d = 0; d < 4; ++d) { const f32x4 v = st.o[h][d] * inv; u32x2 w; w.x = pk2(v[0], v[1]); w.y = pk2(v[2], v[3]);
            *(u32x2*)(O + (size_t)qrow * 1024 + col0 + h * 64 + d * 16 + 4 * quad) = w; } }
}
struct BiasNone { static constexpr bool PLAIN = true; __device__ __forceinline__ float operator()(int, int, int, float s) const { return s * SC2; } };

struct BiasNA { const LAS float* rpb; int kc0, qc, cs, rowoff; static constexpr bool PLAIN = false;
    __device__ __forceinline__ float operator()(int, int ti, int e, float s) const {
        const int kc = kc0 + 16 * ti + e; const bool ok = (kc >= cs) && (kc <= cs + 15);
        int bi = kc - qc + 15; bi = bi < 0 ? 0 : (bi > 30 ? 30 : bi);
        const float bv = rpb[rowoff * 31 + bi];
        return ok ? s * SC2 + bv : -INFINITY; } };
struct BiasNA2 { const LAS unsigned char* tab; int off[8]; int rowb; static constexpr bool PLAIN = false;
    __device__ __forceinline__ float operator()(int, int ti, int e, float s) const { return fmaf(s, SC2, *(const LAS float*)(tab + off[ti * 4 + e] + rowb)); } };
__device__ __forceinline__ void na_unit(int u, const bf16_t* Z, const bf16_t* VTL, const bf16_t* VTC, bf16_t* O, const LAS float* rpb, int lane) {
    const int w4 = u & 3, h = (u >> 2) & 3, r = (u >> 4) & 127, b = u >> 11, l16 = lane & 15, quad = lane >> 4;
    const int q0 = b * SEQ + r * 64 + 16 * w4;
    AttnState<1> st; attn_init<1>(st);
    { const bf16_t* qp = Z + (size_t)(q0 + l16) * ZC + ZQA + h * 64 + quad * 8; st.q[0][0] = *(const bf16x8*)qp; st.q[0][1] = *(const bf16x8*)(qp + 32); }
#pragma unroll 1
    for (int s4 = 0; s4 < 8; s4 += 4) { AttnFrag f[4];
#pragma unroll
        for (int j = 0; j < 4; ++j) { const int s = s4 + j;
            const bf16_t* kr0 = Z + (size_t)(NLAT + b * CTXL + 32 * s + l16) * ZC + ZKA + h * 64 + quad * 8;
            const bf16_t* vt = VTC + ((size_t)((b * 6 + h) * 64 + l16)) * CTXL + 32 * s + 4 * quad;
            attn_load(f[j], kr0, kr0 + 16 * ZC, vt, vt + 16, (size_t)16 * CTXL); }
        asm volatile("" ::: "memory");
#pragma unroll
        for (int j = 0; j < 4; ++j) attn_compute<1>(st, f[j], BiasNone());
    }
    const int rs = min(max(r - 4, 0), 120); const int ksw = (w4 == 0) ? 0 : (w4 == 1 ? 8 : (w4 == 2 ? 24 : 32));
    const int qc = 16 * w4 + l16; const int cs = min(max(qc - 8, 0), 48);
#pragma unroll 1
    for (int k4 = 0; k4 < 8; k4 += 4) { AttnFrag f[4];
#pragma unroll
        for (int j = 0; j < 4; ++j) { const int rabs = rs + k4 + j; const int tok0 = b * SEQ + rabs * 64 + ksw;
            const bf16_t* kr0 = Z + (size_t)(tok0 + l16) * ZC + ZKA + h * 64 + quad * 8;
            const bf16_t* vt = VTL + ((size_t)((b * 6 + h) * 64 + l16)) * SEQ + rabs * 64 + ksw + 4 * quad;
            attn_load(f[j], kr0, kr0 + 16 * ZC, vt, vt + 16, (size_t)16 * SEQ); }
        asm volatile("" ::: "memory");
#pragma unroll
        for (int j = 0; j < 4; ++j) { const BiasNA bf{rpb + h * 465, ksw + 4 * quad, qc, cs, rs + k4 + j - r + 7}; attn_compute<1>(st, f[j], bf); }
    }
    attn_store<1>(st, O, q0 + l16, 0 + h * 64, quad);
}
struct BiasSWA { int kpos0, qpos; static constexpr bool PLAIN = false;
    __device__ __forceinline__ float operator()(int, int ti, int e, float s) const {
        const int kpos = kpos0 + 16 * ti + e; const int d = kpos - qpos;
        const bool ok = (kpos >= 0) && (kpos < SEQ) && (d <= 128) && (d >= -128);
        return ok ? s * SC2 : -INFINITY; } };
__device__ __forceinline__ void swa_unit(int u, const bf16_t* Z, const bf16_t* VTL, const bf16_t* VTC, bf16_t* O, const float* sink, int lane) {
    const int hk = u & 1, tile = u >> 1, l16 = lane & 15, quad = lane >> 4;
    const int q0 = tile * 16, b = q0 >> 13, t0 = q0 & (SEQ - 1);
    AttnState<2> st; attn_init<2>(st);
#pragma unroll
    for (int h = 0; h < 2; ++h) { const bf16_t* qp = Z + (size_t)(q0 + l16) * ZC + ZQD + (2 * hk + h) * 64 + quad * 8; st.q[h][0] = *(const bf16x8*)qp; st.q[h][1] = *(const bf16x8*)(qp + 32); }
#pragma unroll 1
    for (int s4 = 0; s4 < 8; s4 += 4) { AttnFrag f[4];
#pragma unroll
        for (int j = 0; j < 4; ++j) { const int s = s4 + j;
            const bf16_t* kr0 = Z + (size_t)(NLAT + b * CTXL + 32 * s + l16) * ZC + ZKD + hk * 64 + quad * 8;
            const bf16_t* vt = VTC + ((size_t)((b * 6 + 4 + hk) * 64 + l16)) * CTXL + 32 * s + 4 * quad;
            attn_load(f[j], kr0, kr0 + 16 * ZC, vt, vt + 16, (size_t)16 * CTXL); }
        asm volatile("" ::: "memory");
#pragma unroll
        for (int j = 0; j < 4; ++j) attn_compute<2>(st, f[j], BiasNone());
    }
    const bf16_t* vrow = VTL + ((size_t)((b * 6 + 4 + hk) * 64 + l16)) * SEQ;
#pragma unroll 1
    for (int s3 = 0; s3 < 9; s3 += 3) { AttnFrag f[3];
#pragma unroll
        for (int j = 0; j < 3; ++j) { const int kb = t0 - 128 + 32 * (s3 + j);
            const int k0 = min(max(kb + l16, 0), SEQ - 1), k1 = min(max(kb + 16 + l16, 0), SEQ - 1);
            const int v0 = min(max(kb + 4 * quad, 0), SEQ - 4), v1 = min(max(kb + 16 + 4 * quad, 0), SEQ - 4);
            attn_load(f[j], Z + (size_t)(b * SEQ + k0) * ZC + ZKD + hk * 64 + quad * 8, Z + (size_t)(b * SEQ + k1) * ZC + ZKD + hk * 64 + quad * 8, vrow + v0, vrow + v1, (size_t)16 * SEQ); }
        asm volatile("" ::: "memory");
#pragma unroll
        for (int j = 0; j < 3; ++j) { const BiasSWA bf{t0 - 128 + 32 * (s3 + j) + 4 * quad, t0 + l16}; attn_compute<2>(st, f[j], bf); }
    }
#pragma unroll
    for (int h = 0; h < 2; ++h) st.l[h] += fast_exp2(sink[2 * hk + h] * LOG2E - st.m[h]);
    attn_store<2>(st, O, q0 + l16, 768 + 2 * hk * 64, quad);
}
__device__ __forceinline__ void ctx_unit(int u, const bf16_t* Z, const bf16_t* VTC, bf16_t* O, const float* sink, int lane) {
    const int l16 = lane & 15, quad = lane >> 4;
    if (u < 256) {
        const int h = u & 3, qt = (u >> 2) & 15, b = u >> 6; const int q0 = NLAT + b * CTXL + 16 * qt;
        AttnState<1> st; attn_init<1>(st);
        { const bf16_t* qp = Z + (size_t)(q0 + l16) * ZC + ZQA + h * 64 + quad * 8; st.q[0][0] = *(const bf16x8*)qp; st.q[0][1] = *(const bf16x8*)(qp + 32); }
#pragma unroll 1
        for (int s4 = 0; s4 < 8; s4 += 4) { AttnFrag f[4];
#pragma unroll
            for (int j = 0; j < 4; ++j) { const int s = s4 + j;
                const bf16_t* kr0 = Z + (size_t)(NLAT + b * CTXL + 32 * s + l16) * ZC + ZKA + h * 64 + quad * 8;
                const bf16_t* vt = VTC + ((size_t)((b * 6 + h) * 64 + l16)) * CTXL + 32 * s + 4 * quad;
                attn_load(f[j], kr0, kr0 + 16 * ZC, vt, vt + 16, (size_t)16 * CTXL); }
            asm volatile("" ::: "memory");
#pragma unroll
            for (int j = 0; j < 4; ++j) attn_compute<1>(st, f[j], BiasNone());
        }
        attn_store<1>(st, O, q0 + l16, h * 64, quad);
    } else {
        const int v = u - 256; const int hk = v & 1, qt = (v >> 1) & 15, b = v >> 5; const int q0 = NLAT + b * CTXL + 16 * qt;
        AttnState<2> st; attn_init<2>(st);
#pragma unroll
        for (int h = 0; h < 2; ++h) { const bf16_t* qp = Z + (size_t)(q0 + l16) * ZC + ZQD + (2 * hk + h) * 64 + quad * 8; st.q[h][0] = *(const bf16x8*)qp; st.q[h][1] = *(const bf16x8*)(qp + 32); }
#pragma unroll 1
        for (int s4 = 0; s4 < 8; s4 += 4) { AttnFrag f[4];
#pragma unroll
            for (int j = 0; j < 4; ++j) { const int s = s4 + j;
                const bf16_t* kr0 = Z + (size_t)(NLAT + b * CTXL + 32 * s + l16) * ZC + ZKD + hk * 64 + quad * 8;
                const bf16_t* vt = VTC + ((size_t)((b * 6 + 4 + hk) * 64 + l16)) * CTXL + 32 * s + 4 * quad;
                attn_load(f[j], kr0, kr0 + 16 * ZC, vt, vt + 16, (size_t)16 * CTXL); }
            asm volatile("" ::: "memory");
#pragma unroll
            for (int j = 0; j < 4; ++j) attn_compute<2>(st, f[j], BiasNone());
        }
#pragma unroll
        for (int h = 0; h < 2; ++h) st.l[h] += fast_exp2(sink[2 * hk + h] * LOG2E - st.m[h]);
        attn_store<2>(st, O, q0 + l16, 768 + 2 * hk * 64, quad);
    }
}

__device__ __forceinline__ void gmlp_unit(int u, LAS unsigned char* lds, const bf16_t* Z, bf16_t* O, const bf16_t* gws  , const float* gbs  ,
                                          const float* lng, const float* lnb, int wave, int lane) {
    LAS bf16_t* VB = (LAS bf16_t*)lds;
    const int row0 = u * 128, l16 = lane & 15, quad = lane >> 4;
    const f32x4 g4 = *(const f32x4*)(lng + 4 * lane), b4 = *(const f32x4*)(lnb + 4 * lane);
    bf16x8 aw[4][4];
#pragma unroll
    for (int g = 0; g < 4; ++g)
#pragma unroll
        for (int ks = 0; ks < 4; ++ks) aw[g][ks] = *(const bf16x8*)(gws + ((size_t)(g * 128 + 16 * wave + l16)) * 128 + 32 * ks + 8 * quad);
#pragma unroll 1
    for (int bt = 0; bt < 2; ++bt) {
        const int jb = 2 * wave + bt; float v[8][4];
#pragma unroll
        for (int t = 0; t < 8; ++t) { const u32x2 raw = *(const u32x2*)(Z + (size_t)(row0 + 8 * jb + t) * ZC + ZGV + 4 * lane);
            v[t][0] = geluf_(bflo(raw.x)); v[t][1] = geluf_(bfhi(raw.x)); v[t][2] = geluf_(bflo(raw.y)); v[t][3] = geluf_(bfhi(raw.y)); }
#pragma unroll
        for (int t = 0; t < 8; ++t) {
            const float mean = wave_sum((v[t][0] + v[t][1]) + (v[t][2] + v[t][3])) * (1.0f / 256.0f);
            float d0 = v[t][0] - mean, d1 = v[t][1] - mean, d2 = v[t][2] - mean, d3 = v[t][3] - mean;
            const float var = wave_sum((d0 * d0 + d1 * d1) + (d2 * d2 + d3 * d3)) * (1.0f / 256.0f);
            const float rstd = 1.0f / sqrtf(var + EPS);
            v[t][0] = d0 * rstd * g4[0] + b4[0]; v[t][1] = d1 * rstd * g4[1] + b4[1]; v[t][2] = d2 * rstd * g4[2] + b4[2]; v[t][3] = d3 * rstd * g4[3] + b4[3];
        }
#pragma unroll
        for (int q = 0; q < 4; ++q) { u32x4 w; w.x = pk2(v[0][q], v[1][q]); w.y = pk2(v[2][q], v[3][q]); w.z = pk2(v[4][q], v[5][q]); w.w = pk2(v[6][q], v[7][q]);
            *(LAS u32x4*)(VB + ((size_t)(jb * 256 + 4 * lane + q)) * 8) = w; }
    }
    __syncthreads();
#pragma unroll
    for (int g = 0; g < 4; ++g) {
        const bf16x8 (&a)[4] = aw[g];
#pragma unroll
        for (int ct = 0; ct < 4; ++ct) {
            f32x4 acc = (f32x4){0.f, 0.f, 0.f, 0.f};
#pragma unroll
            for (int ks = 0; ks < 4; ++ks) { const bf16x8 bb = *(const LAS bf16x8*)(VB + ((size_t)((4 * ks + quad) * 256 + g * 64 + 16 * ct + l16)) * 8); acc = MFMA16(bb, a[ks], acc); }
            const int i = 16 * wave + l16, c0 = g * 64 + 16 * ct + 4 * quad; const size_t row = (size_t)(row0 + i);
            const float bs = gbs[g * 128 + i]; const u32x2 uw = *(const u32x2*)(Z + row * ZC + ZGU + c0);
            u32x2 o; o.x = pk2(geluf_(bflo(uw.x)) * (acc[0] + bs), geluf_(bfhi(uw.x)) * (acc[1] + bs)); o.y = pk2(geluf_(bflo(uw.y)) * (acc[2] + bs), geluf_(bfhi(uw.y)) * (acc[3] + bs));
            *(u32x2*)(O + row * 1024 + 256 + c0) = o;
        }
    }
    __syncthreads();
}

__device__ __forceinline__ void s5_build(int l, int g, int part, LAS unsigned char* lds, KArgs A, bf16_t* TGp, bf16_t* WS5p, int tid) {
    LAS f32x2* Apow = (LAS f32x2*)lds;
    LAS f32x2* Bb = Apow + 2 * 33 * 64;
    LAS f32x2* Cc = Bb + 2 * 64 * 16;
    LAS f32x2* Kc = Cc + 2 * 16 * 64;
    LAS float* Kt = (LAS float*)(Kc + 128);
    if (tid < 128) {
        const int dir = tid >> 6, p = tid & 63; const int ix = ((l * 2 + dir) * 16 + g) * 64 + p;
        const float lre = fminf(A->in[I_ARE][ix], -1e-4f), lim = A->in[I_AIM][ix]; const float dt = expf(A->in[I_LDT][(l * 2 + dir) * 16 + g]);
        for (int k = 0; k <= 32; ++k) { const float mag = expf(lre * dt * (float)k), ang = lim * dt * (float)k; Apow[(dir * 33 + k) * 64 + p] = (f32x2){mag * cosf(ang), mag * sinf(ang)}; }
        const float mag = expf(lre * dt), abr = mag * cosf(lim * dt), abi = mag * sinf(lim * dt); const float den = lre * lre + lim * lim;
        Kc[dir * 64 + p] = (f32x2){((abr - 1.0f) * lre + abi * lim) / den, (abi * lre - (abr - 1.0f) * lim) / den};
    }
    __syncthreads();
    for (int x = tid; x < 2048; x += 512) {
        { const int dir = x >> 10, p = (x >> 4) & 63, c = x & 15; const int ix = (((l * 2 + dir) * 16 + g) * 64 + p) * 16 + c; const float br = A->in[I_BRE][ix], bi = A->in[I_BIM][ix]; const f32x2 k = Kc[dir * 64 + p];
          Bb[x] = (f32x2){k.x * br - k.y * bi, k.x * bi + k.y * br}; }
        { const int dir = x >> 10, cp = (x >> 6) & 15, p = x & 63; const int ix = (((l * 2 + dir) * 16 + g) * 16 + cp) * 64 + p; Cc[x] = (f32x2){A->in[I_CRE][ix], A->in[I_CIM][ix]}; }
    }
    __syncthreads();
    for (int x4 = tid; x4 < 4096; x4 += 512) {
        const int dir = x4 >> 11, k = (x4 >> 6) & 31, cp = 4 * part + ((x4 >> 4) & 3), c = x4 & 15; const int x = ((dir * 32 + k) * 16 + cp) * 16 + c; float s = 0.f;
        for (int p = 0; p < 64; ++p) { const f32x2 cc = Cc[(dir * 16 + cp) * 64 + p], a = Apow[(dir * 33 + k) * 64 + p], bb = Bb[(dir * 64 + p) * 16 + c];
            const float er = cc.x * a.x - cc.y * a.y, ei = cc.x * a.y + cc.y * a.x; s += er * bb.x - ei * bb.y; }
        Kt[x] = s;
    }
    __syncthreads();
    const float* dvec = A->in[I_D] + l * 256 + g * 16;
    bf16_t* tg = TGp + ((size_t)(l * 16 + g)) * 512 * 768;
    for (int x = tid; x < 128 * 96; x += 512) {
        const int nr = x / 96, ch = x % 96, j = nr >> 2, cp = 4 * part + (nr & 3), n = j * 16 + cp; float o[8];
        if (ch < 64) { const int i = ch >> 1, c0 = (ch & 1) * 8;
#pragma unroll
            for (int q = 0; q < 8; ++q) { const int c = c0 + q; float v = 0.f;
                if (i <= j) v += Kt[((0 * 32 + (j - i)) * 16 + cp) * 16 + c];
                if (i >= j) v += Kt[((1 * 32 + (i - j)) * 16 + cp) * 16 + c];
                if (i == j && c == cp) v += dvec[cp];
                o[q] = v; }
        } else { const int kk = (ch - 64) * 8; const int dir = kk >> 7, ri = (kk >> 6) & 1, p0 = kk & 63; const int pw = dir == 0 ? (j + 1) : (32 - j);
#pragma unroll
            for (int q = 0; q < 8; ++q) { const int p = p0 + q; const f32x2 cc = Cc[(dir * 16 + cp) * 64 + p], a = Apow[(dir * 33 + pw) * 64 + p];
                const float er = cc.x * a.x - cc.y * a.y, ei = cc.x * a.y + cc.y * a.x; o[q] = ri == 0 ? er : -ei; }
        }
        u32x4 w; w.x = pk2(o[0], o[1]); w.y = pk2(o[2], o[3]); w.z = pk2(o[4], o[5]); w.w = pk2(o[6], o[7]);
        *(u32x4*)(tg + (size_t)n * 768 + ch * 8) = w;
    }
    bf16_t* wsp = WS5p + ((size_t)(l * 16 + g)) * 256 * 512;
    for (int x = tid; x < 64 * 64; x += 512) {
        const int n = 64 * part + (x >> 6), ch = x & 63, dir = n >> 7, ri = (n >> 6) & 1, p = n & 63, i = ch >> 1, c0 = (ch & 1) * 8; const int pw = dir == 0 ? (31 - i) : i;
        const f32x2 a = Apow[(dir * 33 + pw) * 64 + p]; float o[8];
#pragma unroll
        for (int q = 0; q < 8; ++q) { const f32x2 bb = Bb[(dir * 64 + p) * 16 + c0 + q]; o[q] = ri == 0 ? (a.x * bb.x - a.y * bb.y) : (a.x * bb.y + a.y * bb.x); }
        u32x4 w; w.x = pk2(o[0], o[1]); w.y = pk2(o[2], o[3]); w.z = pk2(o[4], o[5]); w.w = pk2(o[6], o[7]);
        *(u32x4*)(wsp + (size_t)n * 512 + ch * 8) = w;
    }
    __syncthreads();
}
__device__ __forceinline__ void s5_carry(int id, int l, KArgs A, const float* SLOCp, bf16_t* AS5p) {
    const int p = id & 63, dir = (id >> 6) & 1, g = (id >> 7) & 15, b = id >> 11; const int ix = ((l * 2 + dir) * 16 + g) * 64 + p;
    const float lre = fminf(A->in[I_ARE][ix], -1e-4f), lim = A->in[I_AIM][ix]; const float dt = expf(A->in[I_LDT][(l * 2 + dir) * 16 + g]);
    const float mag = expf(lre * dt * 32.0f), ang = lim * dt * 32.0f; const float ar = mag * cosf(ang), ai = mag * sinf(ang);
    float hr = 0.f, hi = 0.f;
    for (int blk = 0; blk < 33; ++blk) {
        float sr[8], si[8]; int crs[8];
#pragma unroll
        for (int q = 0; q < 8; ++q) { const int o = blk * 8 + q; int cr;
            if (o < 8) cr = 1024 + b * 8 + (dir == 0 ? o : 7 - o); else { const int k = o - 8; cr = b * 256 + (dir == 0 ? k : 255 - k); }
            crs[q] = cr; const float* sp = SLOCp + ((size_t)cr * 16 + g) * 256 + dir * 128 + p; sr[q] = sp[0]; si[q] = sp[64]; }
#pragma unroll
        for (int q = 0; q < 8; ++q) { bf16_t* hp = AS5p + ((size_t)g * S5M + crs[q]) * 768 + 512 + dir * 128 + p; hp[0] = (bf16_t)f2bf(hr); hp[64] = (bf16_t)f2bf(hi);
            const float nr = ar * hr - ai * hi + sr[q], ni = ar * hi + ai * hr + si[q]; hr = nr; hi = ni; }
    }
}

__device__ __forceinline__ void s5_carry_par(int wgi, int tid, int l, KArgs A, const float* SLOCp, bf16_t* AS5p, LAS unsigned char* lds) {
    const int dir = wgi & 1, g = (wgi >> 1) & 15, b = wgi >> 5, seg = tid >> 6, p = tid & 63; const int ix = ((l * 2 + dir) * 16 + g) * 64 + p;
    const float lre = fminf(A->in[I_ARE][ix], -1e-4f), lim = A->in[I_AIM][ix]; const float dt = expf(A->in[I_LDT][(l * 2 + dir) * 16 + g]);
    const float mag = expf(lre * dt * 32.0f), ang = lim * dt * 32.0f; const float ar = mag * cosf(ang), ai = mag * sinf(ang);
    float sr[33], si[33];
#pragma unroll
    for (int j = 0; j < 33; ++j) { const int o = seg * 33 + j; const int cr = (o < 8) ? 1024 + b * 8 + (dir == 0 ? o : 7 - o) : b * 256 + (dir == 0 ? o - 8 : 263 - o);
        const float* sp = SLOCp + ((size_t)cr * 16 + g) * 256 + dir * 128 + p; sr[j] = sp[0]; si[j] = sp[64]; }
    float er = 0.f, ei = 0.f, pr = 1.f, pi = 0.f;
#pragma unroll
    for (int j = 0; j < 33; ++j) { const float nr = ar * er - ai * ei + sr[j], ni = ar * ei + ai * er + si[j]; er = nr; ei = ni;
        const float qr = ar * pr - ai * pi, qi = ar * pi + ai * pr; pr = qr; pi = qi; }
    LAS float* ex = (LAS float*)lds;
    ex[(seg * 64 + p) * 2] = er; ex[(seg * 64 + p) * 2 + 1] = ei;
    __syncthreads();
    float hr = 0.f, hi = 0.f;
    for (int j = 0; j < seg; ++j) { const float cr_ = ex[(j * 64 + p) * 2], ci_ = ex[(j * 64 + p) * 2 + 1]; const float nr = pr * hr - pi * hi + cr_, ni = pr * hi + pi * hr + ci_; hr = nr; hi = ni; }
#pragma unroll
    for (int j = 0; j < 33; ++j) { const int o = seg * 33 + j; const int cr = (o < 8) ? 1024 + b * 8 + (dir == 0 ? o : 7 - o) : b * 256 + (dir == 0 ? o - 8 : 263 - o);
        bf16_t* hp = AS5p + ((size_t)g * S5M + cr) * 768 + 512 + dir * 128 + p; hp[0] = (bf16_t)f2bf(hr); hp[64] = (bf16_t)f2bf(hi);
        const float nr = ar * hr - ai * hi + sr[j], ni = ar * hi + ai * hr + si[j]; hr = nr; hi = ni; }
    __syncthreads();
}

constexpr int AT_STAGE = 32768, AT_NST = 4, AT_RPB = 131072 + 1024;
__device__ __forceinline__ void at_dma(LAS unsigned char* lds, int buf, const bf16_t* K0, const bf16_t* K1, const bf16_t* V0, const bf16_t* V1, size_t vpitch, int wave, int lane) {
    const int hh = wave >> 2; const bf16_t* Kb = hh ? K1 : K0; const bf16_t* Vb = hh ? V1 : V0;
#pragma unroll
    for (int i = 0; i < 4; ++i) { const int j = (wave & 3) * 4 + i, kv = j >> 3, sub = j & 7; const int r = sub * 8 + (lane >> 3), cg = (lane & 7) ^ (r & 7);
        const bf16_t* src = kv ? Vb + (size_t)r * vpitch + cg * 8 : Kb + (size_t)r * ZC + cg * 8;
        __builtin_amdgcn_global_load_lds((const unsigned*)src, (LAS unsigned*)(lds + buf * AT_STAGE + hh * 16384 + kv * 8192 + sub * 1024), 16, 0, 0); }
}
__device__ __forceinline__ void at_frag(AttnFrag& f, const LAS unsigned char* tb, int kb, int l16, int quad) {
    const int r0 = kb + l16, r1 = kb + 16 + l16;
    f.ka0 = *(const LAS bf16x8*)(tb + r0 * 128 + ((quad ^ (r0 & 7)) << 4)); f.ka1 = *(const LAS bf16x8*)(tb + r0 * 128 + (((4 + quad) ^ (r0 & 7)) << 4));
    f.kb0 = *(const LAS bf16x8*)(tb + r1 * 128 + ((quad ^ (r1 & 7)) << 4)); f.kb1 = *(const LAS bf16x8*)(tb + r1 * 128 + (((4 + quad) ^ (r1 & 7)) << 4));
    const int ko = kb + 4 * quad, ko2 = ko + 16;
#pragma unroll
    for (int d = 0; d < 4; ++d) { const int r = d * 16 + l16;
        f.vlo[d] = *(const LAS s16x4*)(tb + 8192 + r * 128 + (((ko >> 3) ^ (r & 7)) << 4) + (ko & 7) * 2);
        f.vhi[d] = *(const LAS s16x4*)(tb + 8192 + r * 128 + (((ko2 >> 3) ^ (r & 7)) << 4) + (ko2 & 7) * 2); }
}
#define AT_WAIT_BAR(n) asm volatile("s_waitcnt vmcnt(" #n ")\n\ts_barrier" ::: "memory")
__device__ __forceinline__ void na_unit2(int u, LAS unsigned char* lds, const bf16_t* Z, const bf16_t* VTL, const bf16_t* VTC, bf16_t* O, int wave, int lane) {
    asm volatile("" : "+v"(lane));
    const int hp = u & 1, r = (u >> 1) & 127, b = u >> 8, hh = wave >> 2, w4 = wave & 3, h = 2 * hp + hh; int l16 = lane & 15, quad = lane >> 4;
    const LAS float* rpb = (const LAS float*)(lds + AT_RPB);
    const int q0 = b * SEQ + r * 64 + 16 * w4;
    AttnState<1> st; attn_init<1>(st);
    { const bf16_t* qp = Z + (size_t)(q0 + l16) * ZC + ZQA + h * 64 + quad * 8; st.q[0][0] = *(const bf16x8*)qp; st.q[0][1] = *(const bf16x8*)(qp + 32); }
    const int rs = min(max(r - 4, 0), 120); const int ksw = (w4 == 0) ? 0 : (w4 == 1 ? 8 : (w4 == 2 ? 24 : 32));
    const int qc = 16 * w4 + l16; const int cs = min(max(qc - 8, 0), 48);
    const bf16_t* Kc = Z + (size_t)(NLAT + b * CTXL) * ZC + ZKA + 2 * hp * 64; const bf16_t* Vc = VTC + ((size_t)((b * 6 + 2 * hp) * 64)) * CTXL;
    const bf16_t* Kw = Z + (size_t)(b * SEQ + rs * 64) * ZC + ZKA + 2 * hp * 64; const bf16_t* Vw = VTL + ((size_t)((b * 6 + 2 * hp) * 64)) * SEQ + rs * 64;
    at_dma(lds, 0, Kc, Kc + 64, Vc, Vc + (size_t)64 * CTXL, CTXL, wave, lane);
    at_dma(lds, 1, Kc + (size_t)64 * ZC, Kc + (size_t)64 * ZC + 64, Vc + 64, Vc + (size_t)64 * CTXL + 64, CTXL, wave, lane);
#pragma unroll 1
    for (int j = 0; j < 6; ++j) {
        AT_WAIT_BAR(0);
        asm volatile("" : "+v"(lane), "+v"(l16), "+v"(quad));
        const int sa = (j & 1) * 2;
        if (j == 0) { at_dma(lds, 2, Kc + (size_t)128 * ZC, Kc + (size_t)128 * ZC + 64, Vc + 128, Vc + (size_t)64 * CTXL + 128, CTXL, wave, lane);
                      at_dma(lds, 3, Kc + (size_t)192 * ZC, Kc + (size_t)192 * ZC + 64, Vc + 192, Vc + (size_t)64 * CTXL + 192, CTXL, wave, lane); }
        else if (j < 5) { const int k = 2 * j - 2;
            at_dma(lds, sa ^ 2, Kw + (size_t)64 * k * ZC, Kw + (size_t)64 * k * ZC + 64, Vw + 64 * k, Vw + (size_t)64 * SEQ + 64 * k, SEQ, wave, lane);
            at_dma(lds, (sa ^ 2) + 1, Kw + (size_t)64 * (k + 1) * ZC, Kw + (size_t)64 * (k + 1) * ZC + 64, Vw + 64 * (k + 1), Vw + (size_t)64 * SEQ + 64 * (k + 1), SEQ, wave, lane); }
        const LAS unsigned char* ta = lds + sa * AT_STAGE + hh * 16384; const LAS unsigned char* tb = ta + AT_STAGE; AttnFrag fa, fb;
        if (j < 2) { at_frag(fa, ta, 0, l16, quad); at_frag(fb, ta, 32, l16, quad); attn_compute2<1>(st, fa, BiasNone(), fb, BiasNone());
                     at_frag(fa, tb, 0, l16, quad); at_frag(fb, tb, 32, l16, quad); attn_compute2<1>(st, fa, BiasNone(), fb, BiasNone()); }
        else { const int kr = 2 * (j - 2); at_frag(fa, ta, ksw, l16, quad); at_frag(fb, tb, ksw, l16, quad);
            const BiasNA b0{rpb + h * 465, ksw + 4 * quad, qc, cs, rs + kr - r + 7}; const BiasNA b1{rpb + h * 465, ksw + 4 * quad, qc, cs, rs + kr + 1 - r + 7};
            attn_compute2<1>(st, fa, b0, fb, b1); }
    }
    attn_store<1>(st, O, q0 + l16, h * 64, quad);
    __builtin_amdgcn_s_barrier();
}
__device__ __forceinline__ void na_unit3(int u, LAS unsigned char* lds, const bf16_t* Z, const bf16_t* VTL, const bf16_t* VTC, bf16_t* O, int wave, int lane) {
    asm volatile("" : "+v"(lane));
    const int hp = u & 1, rp = (u >> 1) & 63, b = u >> 7, hh = wave >> 2, w4 = wave & 3, h = 2 * hp + hh; int l16 = lane & 15, quad = lane >> 4;
    const int r0 = 2 * rp, r1 = r0 + 1; const int q0 = b * SEQ + r0 * 64 + 16 * w4;
    AttnState<1> s0, s1; attn_init<1>(s0); attn_init<1>(s1);
    { const bf16_t* qp = Z + (size_t)(q0 + l16) * ZC + ZQA + h * 64 + quad * 8; s0.q[0][0] = *(const bf16x8*)qp; s0.q[0][1] = *(const bf16x8*)(qp + 32);
      const bf16_t* qq = qp + (size_t)64 * ZC; s1.q[0][0] = *(const bf16x8*)qq; s1.q[0][1] = *(const bf16x8*)(qq + 32); }
    const int rs0 = min(max(r0 - 4, 0), 120), rs1 = min(max(r1 - 4, 0), 120), dd = rs1 - rs0, nwin = 8 + dd, nt = 4 + nwin, nit = (nt + 1) >> 1;
    const int ksw = (w4 == 0) ? 0 : (w4 == 1 ? 8 : (w4 == 2 ? 24 : 32));
    const int qc = 16 * w4 + l16; const int cs = min(max(qc - 8, 0), 48);
    BiasNA2 bna; bna.tab = (const LAS unsigned char*)(lds + AT_RPB); bna.rowb = 0;
#pragma unroll
    for (int j = 0; j < 8; ++j) { const int kc = ksw + 4 * quad + 16 * (j >> 2) + (j & 3); const bool ok = (kc >= cs) && (kc <= cs + 15); int bi = kc - qc + 15; bi = bi < 0 ? 0 : (bi > 30 ? 30 : bi); bna.off[j] = (h * 480 + (ok ? bi : 31)) * 4; }
    const bf16_t* Kc = Z + (size_t)(NLAT + b * CTXL) * ZC + ZKA + 2 * hp * 64; const bf16_t* Vc = VTC + ((size_t)((b * 6 + 2 * hp) * 64)) * CTXL;
    const bf16_t* Kw = Z + (size_t)(b * SEQ + rs0 * 64) * ZC + ZKA + 2 * hp * 64; const bf16_t* Vw = VTL + ((size_t)((b * 6 + 2 * hp) * 64)) * SEQ + rs0 * 64;
    at_dma(lds, 0, Kc, Kc + 64, Vc, Vc + (size_t)64 * CTXL, CTXL, wave, lane);
    at_dma(lds, 1, Kc + (size_t)64 * ZC, Kc + (size_t)64 * ZC + 64, Vc + 64, Vc + (size_t)64 * CTXL + 64, CTXL, wave, lane);
#pragma unroll 1
    for (int j = 0; j < nit; ++j) {
        AT_WAIT_BAR(0);
        asm volatile("" : "+v"(lane), "+v"(l16), "+v"(quad));
        const int sa = (j & 1) * 2;
#pragma unroll
        for (int tt = 0; tt < 2; ++tt) { const int n = 2 * j + 2 + tt;
            if (n < nt) { if (n < 4) at_dma(lds, (sa ^ 2) + tt, Kc + (size_t)64 * n * ZC, Kc + (size_t)64 * n * ZC + 64, Vc + 64 * n, Vc + (size_t)64 * CTXL + 64 * n, CTXL, wave, lane);
                          else { const int k = n - 4; at_dma(lds, (sa ^ 2) + tt, Kw + (size_t)64 * k * ZC, Kw + (size_t)64 * k * ZC + 64, Vw + 64 * k, Vw + (size_t)64 * SEQ + 64 * k, SEQ, wave, lane); } } }
        const LAS unsigned char* ta = lds + sa * AT_STAGE + hh * 16384; const LAS unsigned char* tb = ta + AT_STAGE; AttnFrag fa, fb;
        if (j < 2) { at_frag(fa, ta, 0, l16, quad); at_frag(fb, ta, 32, l16, quad); attn_compute2<1>(s0, fa, BiasNone(), fb, BiasNone()); attn_compute2<1>(s1, fa, BiasNone(), fb, BiasNone());
                     at_frag(fa, tb, 0, l16, quad); at_frag(fb, tb, 32, l16, quad); attn_compute2<1>(s0, fa, BiasNone(), fb, BiasNone()); attn_compute2<1>(s1, fa, BiasNone(), fb, BiasNone()); }
        else { const int ka = 2 * (j - 2), kb = ka + 1; const bool hasb = kb < nwin;
            at_frag(fa, ta, ksw, l16, quad); if (hasb) at_frag(fb, tb, ksw, l16, quad);
            { const bool va = ka <= 7, vb = hasb && kb <= 7;
              BiasNA2 ba = bna, bb = bna; ba.rowb = (rs0 + ka - r0 + 7) * 128; bb.rowb = ba.rowb + 128;
              if (va && vb) attn_compute2<1>(s0, fa, ba, fb, bb); else if (va) attn_compute<1>(s0, fa, ba); else if (vb) attn_compute<1>(s0, fb, bb); }
            { const bool va = ka >= dd, vb = hasb && kb <= dd + 7;
              BiasNA2 ba = bna, bb = bna; ba.rowb = (rs0 + ka - r1 + 7) * 128; bb.rowb = ba.rowb + 128;
              if (va && vb) attn_compute2<1>(s1, fa, ba, fb, bb); else if (va) attn_compute<1>(s1, fa, ba); else if (vb) attn_compute<1>(s1, fb, bb); } }
    }
    attn_store<1>(s0, O, q0 + l16, h * 64, quad); attn_store<1>(s1, O, q0 + 64 + l16, h * 64, quad);
    __builtin_amdgcn_s_barrier();
}
__device__ __forceinline__ void swa_unit2(int u, LAS unsigned char* lds, const bf16_t* Z, const bf16_t* VTL, const bf16_t* VTC, bf16_t* O, const float* sink, int wave, int lane) {
    asm volatile("" : "+v"(lane));
    const int qb = u & 127, b = u >> 7, hk = wave >> 2, j4 = wave & 3; int l16 = lane & 15, quad = lane >> 4;
    const int tb0 = qb * 64, t0 = tb0 + 16 * j4, q0 = b * SEQ + t0;
    AttnState<2> st; attn_init<2>(st);
#pragma unroll
    for (int h = 0; h < 2; ++h) { const bf16_t* qp = Z + (size_t)(q0 + l16) * ZC + ZQD + (2 * hk + h) * 64 + quad * 8; st.q[h][0] = *(const bf16x8*)qp; st.q[h][1] = *(const bf16x8*)(qp + 32); }
    const int wlo = tb0 >= 128 ? 0 : (128 - tb0) / 64; int whi = (SEQ - tb0 + 128) / 64; whi = whi > 5 ? 5 : whi; const int ns = 4 + whi - wlo;
    const bf16_t* Kc = Z + (size_t)(NLAT + b * CTXL) * ZC + ZKD; const bf16_t* Vc = VTC + ((size_t)((b * 6 + 4) * 64)) * CTXL;
    const int key00 = tb0 - 128 + 64 * wlo;
    const bf16_t* Kw = Z + (size_t)(b * SEQ + key00) * ZC + ZKD; const bf16_t* Vw = VTL + ((size_t)((b * 6 + 4) * 64)) * SEQ + key00;
    at_dma(lds, 0, Kc, Kc + 64, Vc, Vc + (size_t)64 * CTXL, CTXL, wave, lane);
    at_dma(lds, 1, Kc + (size_t)64 * ZC, Kc + (size_t)64 * ZC + 64, Vc + 64, Vc + (size_t)64 * CTXL + 64, CTXL, wave, lane);
    const int nit = (ns + 1) >> 1;
#pragma unroll 1
    for (int j = 0; j < nit; ++j) {
        AT_WAIT_BAR(0);
        asm volatile("" : "+v"(lane), "+v"(l16), "+v"(quad));
        const int sa = (j & 1) * 2;
        if (j == 0) { at_dma(lds, 2, Kc + (size_t)128 * ZC, Kc + (size_t)128 * ZC + 64, Vc + 128, Vc + (size_t)64 * CTXL + 128, CTXL, wave, lane);
                      at_dma(lds, 3, Kc + (size_t)192 * ZC, Kc + (size_t)192 * ZC + 64, Vc + 192, Vc + (size_t)64 * CTXL + 192, CTXL, wave, lane); }
        else { const int k = 2 * j - 2;
            if (k + 4 < ns) at_dma(lds, sa ^ 2, Kw + (size_t)64 * k * ZC, Kw + (size_t)64 * k * ZC + 64, Vw + 64 * k, Vw + (size_t)64 * SEQ + 64 * k, SEQ, wave, lane);
            if (k + 5 < ns) at_dma(lds, (sa ^ 2) + 1, Kw + (size_t)64 * (k + 1) * ZC, Kw + (size_t)64 * (k + 1) * ZC + 64, Vw + 64 * (k + 1), Vw + (size_t)64 * SEQ + 64 * (k + 1), SEQ, wave, lane); }
        const LAS unsigned char* ta = lds + sa * AT_STAGE + hk * 16384; AttnFrag fa, fb;
        if (j < 2) { at_frag(fa, ta, 0, l16, quad); at_frag(fb, ta, 32, l16, quad); attn_compute2<2>(st, fa, BiasNone(), fb, BiasNone());
                     at_frag(fa, ta + AT_STAGE, 0, l16, quad); at_frag(fb, ta + AT_STAGE, 32, l16, quad); attn_compute2<2>(st, fa, BiasNone(), fb, BiasNone()); }
        else {
#pragma unroll
            for (int tt = 0; tt < 2; ++tt) { const int s = 2 * j + tt;
                if (s < ns) { const LAS unsigned char* tb = ta + tt * AT_STAGE; const int key0 = key00 + 64 * (s - 4);
                    const bool ok0 = (key0 + 31 >= t0 - 128) && (key0 <= t0 + 15 + 128), ok1 = (key0 + 63 >= t0 - 128) && (key0 + 32 <= t0 + 15 + 128);
                    if (ok0 && ok1) { at_frag(fa, tb, 0, l16, quad); at_frag(fb, tb, 32, l16, quad);
                        const BiasSWA b0{key0 + 4 * quad, t0 + l16}; const BiasSWA b1{key0 + 32 + 4 * quad, t0 + l16}; attn_compute2<2>(st, fa, b0, fb, b1); }
                    else if (ok0) { at_frag(fa, tb, 0, l16, quad); const BiasSWA b0{key0 + 4 * quad, t0 + l16}; attn_compute<2>(st, fa, b0); }
                    else if (ok1) { at_frag(fa, tb, 32, l16, quad); const BiasSWA b1{key0 + 32 + 4 * quad, t0 + l16}; attn_compute<2>(st, fa, b1); } } }
        }
    }
#pragma unroll
    for (int h = 0; h < 2; ++h) st.l[h] += fast_exp2(sink[2 * hk + h] * LOG2E - st.m[h]);
    attn_store<2>(st, O, q0 + l16, 768 + 2 * hk * 64, quad);
    __builtin_amdgcn_s_barrier();
}
struct Row16 { f32x4 v[4]; };
__device__ __forceinline__ Row16 row_load_f32(const float* p, int lane) { Row16 r; const f32x4* q = (const f32x4*)p + lane;
#pragma unroll
    for (int j = 0; j < 4; ++j) r.v[j] = q[64 * j]; return r; }
__device__ __forceinline__ void row_store_f32(float* p, const Row16& r, int lane) { f32x4* q = (f32x4*)p + lane;
#pragma unroll
    for (int j = 0; j < 4; ++j) q[64 * j] = r.v[j]; }
__device__ __forceinline__ Row16 row_load_bf16(const bf16_t* p, int lane) { Row16 r; const u32x2* q = (const u32x2*)p + lane;
#pragma unroll
    for (int j = 0; j < 4; ++j) { const u32x2 w = q[64 * j]; r.v[j] = (f32x4){bflo(w.x), bfhi(w.x), bflo(w.y), bfhi(w.y)}; } return r; }
__device__ __forceinline__ void row_store_bf16(bf16_t* p, const Row16& r, int lane) { u32x2* q = (u32x2*)p + lane;
#pragma unroll
    for (int j = 0; j < 4; ++j) { u32x2 w; w.x = pk2(r.v[j][0], r.v[j][1]); w.y = pk2(r.v[j][2], r.v[j][3]); q[64 * j] = w; } }
__device__ __forceinline__ float row_rstd(const Row16& r) { float s = 0.f;
#pragma unroll
    for (int j = 0; j < 4; ++j) s += (r.v[j][0] * r.v[j][0] + r.v[j][1] * r.v[j][1]) + (r.v[j][2] * r.v[j][2] + r.v[j][3] * r.v[j][3]);
    return 1.0f / sqrtf(wave_sum(s) * (1.0f / DM) + EPS); }
__device__ __forceinline__ Row16 row_norm_mod(const Row16& x, const float* g, const float* sc, const float* sh, int lane) {
    const float rstd = row_rstd(x); Row16 y; const f32x4* gq = (const f32x4*)g + lane; const f32x4* scq = (const f32x4*)sc + lane; const f32x4* shq = (const f32x4*)sh + lane;
#pragma unroll
    for (int j = 0; j < 4; ++j) y.v[j] = x.v[j] * rstd * gq[64 * j] * (scq[64 * j] + 1.0f) + shq[64 * j];
    return y; }
__device__ __forceinline__ Row16 row_resid(const Row16& x, const Row16& f, const float* g, const float* gate, int lane) {
    const float rstd = row_rstd(f); Row16 y; const f32x4* gq = (const f32x4*)g + lane; const f32x4* gt = (const f32x4*)gate + lane;
#pragma unroll
    for (int j = 0; j < 4; ++j) y.v[j] = x.v[j] + gt[64 * j] * (f.v[j] * rstd * gq[64 * j]);
    return y; }

__device__ __forceinline__ Row16 row_norm_mod_t(const Row16& x, const Row16& g, const Row16& sc, const Row16& sh) {
    const float rstd = row_rstd(x); Row16 y;
#pragma unroll
    for (int j = 0; j < 4; ++j) y.v[j] = x.v[j] * rstd * g.v[j] * (sc.v[j] + 1.0f) + sh.v[j];
    return y; }
__device__ __forceinline__ Row16 row_resid_t(const Row16& x, const Row16& f, const Row16& g, const Row16& gate) {
    const float rstd = row_rstd(f); Row16 y;
#pragma unroll
    for (int j = 0; j < 4; ++j) y.v[j] = x.v[j] + gate.v[j] * (f.v[j] * rstd * g.v[j]);
    return y; }
template <int MODE> __device__ __forceinline__ int tr_dest_row(int c, int p0) {
    if (MODE == 0) return p0 + c;
    if (MODE == 3) return p0 + (c & ~31) + 16 * ((c >> 2) & 1) + 4 * ((c >> 3) & 3) + (c & 3);
    if (MODE == 1) return 256 * (c >> 6) + 128 * (p0 >> 1) + 32 * ((c >> 4) & 3) + 16 * (p0 & 1) + (c & 15);
    return 256 * (c >> 7) + 128 * ((c >> 2) & 1) + 32 * ((c >> 5) & 3) + 16 * p0 + 4 * ((c >> 3) & 3) + (c & 3);
}
template <int MODE> __device__ __forceinline__ void tr_item(const float* W, int ld, int col0  , int c0  , int k0,
                                                            bf16_t* WT, int ldd, int koff, int p0, LAS float* scr, int lane) {
#pragma unroll 8
    for (int i = 0; i < 32; ++i) { const int kk = 2 * i + (lane >> 5); scr[kk * 33 + (lane & 31)] = W[(size_t)(k0 + kk) * ld + col0 + (lane & 31)]; }
    asm volatile("s_waitcnt lgkmcnt(0)" ::: "memory");
    const int c = lane & 7;
#pragma unroll
    for (int j = 0; j < 4; ++j) { const int n = (lane >> 3) + 8 * j; const LAS float* s = scr + (8 * c) * 33 + n;
        u32x4 o; o.x = pk2(s[0 * 33], s[1 * 33]); o.y = pk2(s[2 * 33], s[3 * 33]); o.z = pk2(s[4 * 33], s[5 * 33]); o.w = pk2(s[6 * 33], s[7 * 33]);
        *(u32x4*)(WT + (size_t)tr_dest_row<MODE>(c0 + n, p0) * ldd + koff + k0 + 8 * c) = o; }
    asm volatile("s_waitcnt lgkmcnt(0)" ::: "memory");
}
template <int MODE> __device__ __forceinline__ void tr_item8(const float* W, int ld, int col0, int c0, int k0, unsigned char* WT, int ldd, int p0, float scale, LAS float* scr, int lane) {
#pragma unroll 8
    for (int i = 0; i < 32; ++i) { const int kk = 2 * i + (lane >> 5); scr[kk * 33 + (lane & 31)] = W[(size_t)(k0 + kk) * ld + col0 + (lane & 31)]; }
    asm volatile("s_waitcnt lgkmcnt(0)" ::: "memory");
    const int c = lane & 7;
#pragma unroll
    for (int j = 0; j < 4; ++j) { const int n = (lane >> 3) + 8 * j; const LAS float* sp = scr + (8 * c) * 33 + n;
        u32x2 o; o.x = pk4_fp8(sp[0 * 33] * scale, sp[1 * 33] * scale, sp[2 * 33] * scale, sp[3 * 33] * scale); o.y = pk4_fp8(sp[4 * 33] * scale, sp[5 * 33] * scale, sp[6 * 33] * scale, sp[7 * 33] * scale);
        *(u32x2*)(WT + (size_t)tr_dest_row<MODE>(c0 + n, p0) * ldd + k0 + 8 * c) = o; }
    asm volatile("s_waitcnt lgkmcnt(0)" ::: "memory");
}
__device__ __forceinline__ int zmap(int c) {
    if (c < 512) return c;
    if (c < 768) return 1536 + (c - 512);
    if (c < 1024) return 512 + (c - 768);
    if (c < 1152) return 1280 + (c - 1024);
    if (c < 1280) return 1408 + (c - 1152);
    if (c < 1792) return 768 + (c - 1280);
    return c;
}
constexpr int PH_PER_LAYER = 32, N_PHASES = 1 + 2 * PH_PER_LAYER;
__device__ __forceinline__ void moe_load(LAS int* base, const LAS int* grp, int q, int tid) {
    __syncthreads();
    if (tid < 9) base[tid] = grp[16 + q * 16 + tid];
    if (tid == 16) base[16] = grp[0];
    if (tid == 17) base[17] = grp[1 + q];
    if (tid == 18) base[18] = grp[2 + q];
    if (tid == 19) base[19] = q > 0 ? grp[q] : 0;
    __syncthreads();
}
__device__ __forceinline__ KArgs kargs() { KArgs p = (KArgs)__builtin_amdgcn_kernarg_segment_ptr(); asm volatile("" : "+s"(p)); return p; }
#define PHASE_PTRS int tid; asm volatile("v_mbcnt_lo_u32_b32 %0, -1, 0\n\tv_mbcnt_hi_u32_b32 %0, -1, %0" : "=v"(tid)); tid += wave_s * 64; asm volatile("" : "+v"(tid)); const int lane = tid & 63, wave = __builtin_amdgcn_readfirstlane(tid >> 6); const int gw = bx * 8 + wave; (void)lane; (void)gw; KArgs A = kargs(); unsigned char* const ws = A->ws; float* const out = A->out; (void)out; unsigned* const ctl = (unsigned*)(ws + WS_CTL); (void)ctl; float* const MOD = (float*)(ws + WS_MOD); (void)MOD
#define ROPEC ((float*)(ws + WS_ROPE))
#define ROPES (ROPEC + 2048)
#define TOPI ((int*)(ws + WS_TOPI))
#define TOPW ((float*)(ws + WS_TOPW))
#define SLOT ((int*)(ws + WS_SLOT))
#define ROWTOK ((int*)(ws + WS_ROWTOK))
#define WCNT ((int*)(ws + WS_WCNT))
#define GRP ((int*)(ws + WS_GRP))
#define GLUT ((bf16_t*)(ws + WS_GLUT))
#define GWS ((bf16_t*)(ws + WS_GWS))
#define WS5 ((bf16_t*)(ws + WS_WS5))
#define TG ((bf16_t*)(ws + WS_TG))
#define WIN_T ((bf16_t*)(ws + WS_WIN))
#define WG_T ((bf16_t*)(ws + WS_WG))
#define WBR_T ((bf16_t*)(ws + WS_WBR))
#define WOUT_T ((bf16_t*)(ws + WS_WOUT))
#define W13_T ((bf16_t*)(ws + WS_W13))
#define W2_T ((bf16_t*)(ws + WS_W2))
#define MW13_T ((bf16_t*)(ws + WS_MW13))
#define MW2_T ((bf16_t*)(ws + WS_MW2))
#define HCTX ((float*)(ws + WS_HCTX))
#define VTL ((bf16_t*)(ws + WS_VTL))
#define VTC ((bf16_t*)(ws + WS_VTC))
#define HX ((bf16_t*)(ws + WS_HX))
#define Z ((bf16_t*)(ws + WS_Z))
#define O ((bf16_t*)(ws + WS_O))
#define AS5 ((bf16_t*)(ws + WS_AS5))
#define SLOC ((float*)(ws + WS_SLOC))
#define YS5 ((bf16_t*)(ws + WS_YS5))
#define MB ((bf16_t*)(ws + WS_MB))
#define HB ((bf16_t*)(ws + WS_H))
#define MY ((bf16_t*)(ws + WS_MY))
#define MH ((bf16_t*)(ws + WS_MH))
#define PARTB ((float*)(ws + WS_PART))
#define HXM8 ((unsigned char*)(ws + WS_MW13 + 56 * MiB))
#define HX8 ((unsigned char*)(ws + WS_PART))
#define SPLIT_GEMM(EpiT, BaseT, GATH, g, S0, E, ntk) pg8::gemm_phase<EpiT, BaseT, GATH>(lds, g, S0, E, tid)
__global__ void __launch_bounds__(512, 2) fwd(Args args) {
    extern __shared__ __attribute__((aligned(16))) unsigned char lds_raw[];
    LAS unsigned char* lds = (LAS unsigned char*)lds_raw;
    volatile LAS unsigned* MISC = (volatile LAS unsigned*)(lds + MISC_OFF);
    const int G = gridDim.x, bx = blockIdx.x, NGW = G * 8;
    const int vc = (bx & 7) * (G >> 3) + (bx >> 3);
    LAS int* mbase = (LAS int*)(lds + RING_BYTES);

    const int wave_s = __builtin_amdgcn_readfirstlane(threadIdx.x >> 6);
    if (threadIdx.x < 64) MISC[threadIdx.x] = 0u;
    __syncthreads();
#if MK_MULTI
#define SEAM() do { } while (0)
#else
    const XcdBarrier bar = xcd_barrier_post((unsigned*)(args.ws + WS_CTL) + CW_BAR, MISC + 8);
#define SEAM() xcd_barrier(bar, tid)
#endif
#ifndef SITE_MASK
#define SITE_MASK 0xFFFFFFFFu
#endif
#ifndef DUP_MASK
#define DUP_MASK 0u
#endif
#define DUPN(site) ((((DUP_MASK) >> (site)) & 1u) ? 2 : 1)
#define RUN(site, ph) ((((SITE_MASK) >> (site)) & 1u) && args.ph_lo <= (ph) && (ph) < args.ph_hi)

    if (RUN(0, 0)) for (int rep_ = 0; rep_ < DUPN(0); ++rep_) { PHASE_PTRS;
        LAS float* SIL = (LAS float*)lds;
        for (int i = tid; i < 5120; i += 512) { const int bi = i >> 10, k = i & 1023; const float v = bi < 4 ? A->in[I_C][bi * 1024 + k] : A->in[I_CCTX][k]; SIL[i] = siluf_(v); }
        __syncthreads();
        { LAS float* red = (LAS float*)(lds + 24576);
          for (int it = bx; it < 768; it += G) {
            const int l = it / 384, col = (it % 384) * 16 + (lane & 15), kq = lane >> 4; float a[5] = {0.f, 0.f, 0.f, 0.f, 0.f};
            const float* wp = A->in[I_WMOD] + (size_t)l * 1024 * 6144 + col;
#pragma unroll 8
            for (int k = 128 * wave + kq; k < 128 * wave + 128; k += 4) { const float w = wp[(size_t)k * 6144];
#pragma unroll
                for (int b = 0; b < 5; ++b) a[b] += SIL[b * 1024 + k] * w; }
#pragma unroll
            for (int b = 0; b < 5; ++b) { a[b] += __shfl_xor(a[b], 16); a[b] += __shfl_xor(a[b], 32); }
            if (lane < 16) {
#pragma unroll
                for (int b = 0; b < 5; ++b) red[(wave * 5 + b) * 16 + lane] = a[b]; }
            __syncthreads();
            if (tid < 80) { const int b = tid >> 4, c = tid & 15; float sum = 0.f;
#pragma unroll
                for (int w = 0; w < 8; ++w) sum += red[(w * 5 + b) * 16 + c];
                const int cc = (it % 384) * 16 + c; MOD[(l * 5 + b) * 6144 + cc] = sum + A->in[I_BMOD][l * 6144 + cc]; }
            __syncthreads();
          } }
        for (int i = bx * 512 + tid; i < 2048; i += G * 512) { const int pos = i >> 4, f = i & 15; const float inv = powf(10000.0f, -(float)f / 16.0f); const float ang = (float)pos * inv; ROPEC[i] = cosf(ang); ROPES[i] = sinf(ang); }
        for (int i = bx * 512 + tid; i < 131072; i += G * 512) GWS[i] = (bf16_t)f2bf(A->in[I_GWS][i]);
        __syncthreads();
        for (int it = bx; it < 128; it += G) s5_build(it >> 6, (it >> 2) & 15, it & 3, lds, A, TG, WS5, tid);
        __syncthreads();
        LAS float* scr = (LAS float*)(lds + wave * 8448);
        constexpr int T_LAYER = 1024 + 2048 + 512 + 512 + 32, T_FFN = 3 * 1408, T_EXP = 3 * 1792, T_ALL = 2 * T_LAYER + T_FFN + 8 * T_EXP;
        const int grp_ = (bx >= 128) ? 1 : 0, a_ = (bx & 127) * 8 + wave;
        for (int k_ = grp_ ? 22 : 0; k_ < (grp_ ? 55 : 22); ++k_) { const int it = k_ * 1024 + a_; if (it >= T_ALL) break;
            int r = it;
            if (r < 2 * T_LAYER) { const int l = r / T_LAYER; r %= T_LAYER;
                if (r < 1024) { const int kb = r >> 6, cb = r & 63; if (FP8_P2) tr_item8<0>(A->in[I_WIN] + (size_t)l * 1024 * 6144, 6144, cb * 32, 0, kb * 64, (unsigned char*)(WIN_T + (size_t)l * 2048 * 1024), 1024, zmap(cb * 32), 32.0f, scr, lane); else tr_item<0>(A->in[I_WIN] + (size_t)l * 1024 * 6144, 6144, cb * 32, 0, kb * 64, WIN_T + (size_t)l * 2048 * 1024, 1024, 0, zmap(cb * 32), scr, lane); continue; } r -= 1024;
                if (r < 2048) { const int kb = r >> 7, cb = r & 127; const int i = cb >> 5, c = (cb & 31) * 32; tr_item8<0>(A->in[I_WIN] + (size_t)l * 1024 * 6144, 6144, 2048 + i * 1024 + c, 0, kb * 64, (unsigned char*)(WG_T + (size_t)l * 4096 * 512), 1024, i * 1024 + c, 32.0f, scr, lane); continue; } r -= 2048;
                if (r < 512) { const int i = r >> 7, kb = (r >> 5) & 3, cb = r & 31; tr_item<0>(A->in[I_WBR] + (size_t)(l * 4 + i) * 256 * 1024, 1024, cb * 32, 0, kb * 64, WBR_T + (size_t)l * 4096 * 512, 512, 0, i * 1024 + cb * 32, scr, lane); continue; } r -= 512;
                if (r < 512) { const int kb = r >> 5, cb = r & 31; tr_item<3>(A->in[I_WOUT] + (size_t)l * 1024 * 1024, 1024, cb * 32, 0, kb * 64, WOUT_T + (size_t)l * 1024 * 1024, 1024, 0, cb * 32, scr, lane); continue; } r -= 512;
                { const int kb = r >> 3, cb = r & 7; tr_item<0>(A->in[I_GLUW] + (size_t)l * 65536, 256, cb * 32, 0, kb * 64, GLUT + (size_t)l * 65536, 256, 0, cb * 32, scr, lane); continue; }
            }
            r -= 2 * T_LAYER;
            if (r < T_FFN) {
                if (r < 1408) { const int kb = r / 88, cb = r % 88; if (FP8_FFN_UP) tr_item8<2>(A->in[I_F1], FFN, cb * 32, cb * 32, kb * 64, (unsigned char*)W13_T, 1024, 0, 32.0f, scr, lane); else tr_item<2>(A->in[I_F1], FFN, cb * 32, cb * 32, kb * 64, W13_T, 1024, 0, 0, scr, lane); continue; } r -= 1408;
                if (r < 1408) { const int kb = r / 88, cb = r % 88; if (FP8_FFN_UP) tr_item8<2>(A->in[I_F3], FFN, cb * 32, cb * 32, kb * 64, (unsigned char*)W13_T, 1024, 1, 32.0f, scr, lane); else tr_item<2>(A->in[I_F3], FFN, cb * 32, cb * 32, kb * 64, W13_T, 1024, 0, 1, scr, lane); continue; } r -= 1408;
                { const int kb = r >> 5, cb = r & 31; if (FP8_FFN_DN) tr_item8<3>(A->in[I_F2], 1024, cb * 32, 0, kb * 64, (unsigned char*)W2_T, FFN, cb * 32, 64.0f, scr, lane); else tr_item<3>(A->in[I_F2], 1024, cb * 32, 0, kb * 64, W2_T, FFN, 0, cb * 32, scr, lane); continue; }
            }
            r -= T_FFN;
            { const int e = r / T_EXP; r %= T_EXP;
                if (r < 1792) { const int kb = r / 112, cb = r % 112; tr_item8<2>(A->in[I_M1] + (size_t)e * 1024 * EXD, EXD, cb * 32, cb * 32, kb * 64, (unsigned char*)MW13_T + (size_t)e * 7168 * 1024, 1024, 0, 32.0f, scr, lane); continue; } r -= 1792;
                if (r < 1792) { const int kb = r / 112, cb = r % 112; tr_item8<2>(A->in[I_M3] + (size_t)e * 1024 * EXD, EXD, cb * 32, cb * 32, kb * 64, (unsigned char*)MW13_T + (size_t)e * 7168 * 1024, 1024, 1, 32.0f, scr, lane); continue; } r -= 1792;
                { const int kb = r >> 5, cb = r & 31; tr_item8<3>(A->in[I_M2] + (size_t)e * EXD * 1024, 1024, cb * 32, 0, kb * 64, (unsigned char*)MW2_T + (size_t)e * 1024 * EXD, EXD, cb * 32, 64.0f, scr, lane); continue; }
            }
        }
        SEAM();
    }

#pragma unroll 1
    for (int l = 0; l < 2; ++l) {
        const int P = 1 + l * PH_PER_LAYER;
        const int nrow = (l == 0) ? NROW : NLAT;
        const int nMt = nrow / 256;


        if (l == 0 && RUN(1, P + 0)) for (int rep_ = 0; rep_ < DUPN(1); ++rep_) { PHASE_PTRS;
            { const Row16 Tg = row_load_f32(A->in[I_GPREMIX], lane); Row16 Tsc{}, Tsh{}; int cbi = -1;
              const int r0 = gw * 17, r1 = (r0 + 17 < NROW) ? r0 + 17 : NROW;
              Row16 xn{}; if (r0 < r1) xn = row_load_f32(r0 < NLAT ? A->in[I_X] + (size_t)r0 * DM : A->in[I_CTX] + (size_t)(r0 - NLAT) * DM, lane);
              for (int r = r0; r < r1; ++r) { const int bi = r < NLAT ? (r >> 13) : 4;
                if (bi != cbi) { const float* mb = (MOD + (size_t)l * 5 * 6144) + bi * 6144; Tsc = row_load_f32(mb + 1024, lane); Tsh = row_load_f32(mb, lane); cbi = bi; }
                const Row16 x = xn; const int rn = r + 1;
                if (rn < r1) xn = row_load_f32(rn < NLAT ? A->in[I_X] + (size_t)rn * DM : A->in[I_CTX] + (size_t)(rn - NLAT) * DM, lane);
                const Row16 y = row_norm_mod_t(x, Tg, Tsc, Tsh); row_store_bf16(HX + (size_t)r * DM, y, lane);
                { unsigned* h8 = (unsigned*)(HXM8 + (size_t)r * DM) + lane;
#pragma unroll
                  for (int j = 0; j < 4; ++j) h8[64 * j] = pk4_fp8(y.v[j][0], y.v[j][1], y.v[j][2], y.v[j][3]); } } }
            SEAM();
        }
        if (RUN(2, P + 1)) for (int rep_ = 0; rep_ < DUPN(2); ++rep_) { PHASE_PTRS;
            const EpiZ E{Z, VTL, VTC, AS5, ROPEC, ROPES};
            if constexpr (FP8_P2) { const pg8::Gemm g{(const bf16_t*)HXM8, (const bf16_t*)HXM8, WIN_T + (size_t)l * 2048 * 1024, WIN_T, 512, 512, 1024, nullptr, nullptr, 0x7A7A7A7A, 0x7F7F7F7F, 0}; const Sched2D S{132, 8, G, vc, 0, 0, 8, 1};
                pg8::gemm_phase<EpiZ, Sched2D, false, false, true>(lds, g, S, E, tid); }
            else { const pg8::Gemm g{HX, HX, WIN_T + (size_t)l * 2048 * 1024, WIN_T, 1024, 1024, 1024, nullptr, PARTB, 0, 0x7F7F7F7F, 0}; const Sched2D S{132, 8, G, vc, 0, 0, 16, 1};
                pg8::gemm_phase<EpiZ, Sched2D>(lds, g, S, E, tid); }
            SEAM();
        }
        if (RUN(3, P + 2)) for (int rep_ = 0; rep_ < DUPN(3); ++rep_) { PHASE_PTRS;
            { const pg8::Gemm g{AS5, AS5, WS5 + (size_t)l * 16 * 256 * 512, WS5, 768, 512, 512, nullptr, nullptr, 0, 0x7F7F7F7F, 0}; const SchedS5 S{1, G, vc, S5M * 768, 256 * 512, 8}; const EpiSloc E{SLOC};
              pg8::gemm_phase<EpiSloc, SchedS5>(lds, g, S, E, tid); }
            LAS float* rpb = (LAS float*)(lds + AT_RPB);
            for (int i = tid; i < 4 * 480; i += 512) { const int hh_ = i / 480, rem = i % 480, rw = rem >> 5, cl = rem & 31; rpb[i] = (cl < 31) ? A->in[I_RPB][l * 4 * 465 + hh_ * 465 + rw * 31 + cl] * LOG2E : -INFINITY; }
            __syncthreads();
            for (int r2 = 0; r2 < DUPN(17); ++r2) {
                if (vc >= 80) na_unit3(vc - 80, lds, Z, VTL, VTC, O, wave, lane); }
            SEAM();
        }
        if (RUN(4, P + 3)) for (int rep_ = 0; rep_ < DUPN(4); ++rep_) { PHASE_PTRS;
            if (vc < 128) { for (int r2 = 0; r2 < DUPN(16); ++r2) s5_carry_par(vc, tid, l, A, SLOC, AS5, lds); }
            for (int r2 = 0; r2 < DUPN(18); ++r2) for (int u = G - 1 - bx; u < 512; u += G) swa_unit2(u, lds, Z, VTL, VTC, O, A->in[I_SINK] + l * 4, wave, lane);
            SEAM();
        }
        if (RUN(5, P + 4)) for (int rep_ = 0; rep_ < DUPN(5); ++rep_) { PHASE_PTRS;
            { const pg8::Gemm g{AS5, AS5, TG + (size_t)l * 16 * 512 * 768, TG, 768, 768, 768, nullptr, nullptr, 0, 0x7F7F7F7F, 0}; const SchedS5 S{2, G, vc, S5M * 768, 512 * 768, 12}; const EpiY E{YS5};
              pg8::gemm_phase<EpiY, SchedS5>(lds, g, S, E, tid); }
            __syncthreads();
            const int ng = (l == 0) ? 264 : 256; const int fo = (vc >= 160) ? vc - 160 : 96 + vc;
            for (int u = fo; u < ng; u += G) gmlp_unit(u, lds, Z, O, GWS + (size_t)l * 4 * 128 * 128, A->in[I_GBS] + l * 512, A->in[I_LNG] + l * 256, A->in[I_LNB] + l * 256, wave, lane);
            if (fo >= 8 && fo < 96) {
                __syncthreads();
                LAS float* rpb = (LAS float*)(lds + AT_RPB);
                for (int i = tid; i < 4 * 480; i += 512) { const int hh_ = i / 480, rem = i % 480, rw = rem >> 5, cl = rem & 31; rpb[i] = (cl < 31) ? A->in[I_RPB][l * 4 * 465 + hh_ * 465 + rw * 31 + cl] * LOG2E : -INFINITY; }
                __syncthreads();
                na_unit3(176 + fo - 8, lds, Z, VTL, VTC, O, wave, lane); }
            SEAM();
        }
        if (RUN(6, P + 5)) for (int rep_ = 0; rep_ < DUPN(6); ++rep_) { PHASE_PTRS;
            const pg8::Gemm g{YS5, YS5, GLUT + (size_t)l * 65536, GLUT, 256, 256, 256, nullptr, nullptr, 0, 0x7F7F7F7F, 0}; const Sched2D S{nMt, 1, G, vc, 0, 0, 4, 0}; const EpiGlu E{YS5, A->in[I_GLUB] + l * 256, O};
            pg8::gemm_phase<EpiGlu, Sched2D>(lds, g, S, E, tid);
            if (l == 0 && vc >= 208) { const int u = (vc - 208) * 8 + wave; ctx_unit(u, Z, VTC, O, A->in[I_SINK] + l * 4, lane); }
            if (vc < 248) {
                __syncthreads();
                LAS float* rpb = (LAS float*)(lds + AT_RPB);
                for (int i = tid; i < 4 * 480; i += 512) { const int hh_ = i / 480, rem = i % 480, rw = rem >> 5, cl = rem & 31; rpb[i] = (cl < 31) ? A->in[I_RPB][l * 4 * 465 + hh_ * 465 + rw * 31 + cl] * LOG2E : -INFINITY; }
                __syncthreads();
                na_unit3(264 + vc, lds, Z, VTL, VTC, O, wave, lane); }
            SEAM();
        }
        if (RUN(7, P + 6)) for (int rep_ = 0; rep_ < DUPN(7); ++rep_) { PHASE_PTRS;
            const pg8::Gemm g{(const bf16_t*)HXM8, O, WG_T + (size_t)l * 4096 * 512, WBR_T + (size_t)l * 4096 * 512, 512, 512, 1024, nullptr, nullptr, 0x7A7A7A7A, 0x7F7F7F7F, 1024}; const SchedMerge S{0, 1024, G, vc};
            EpiMerge E{}; E.outp = MB;
            pg8::gemm_phase<EpiMerge, SchedMerge, false, true, false, true>(lds, g, S, E, tid);
            SEAM();
        }
        if (RUN(8, P + 7)) for (int rep_ = 0; rep_ < DUPN(8); ++rep_) { PHASE_PTRS;
            if (l == 0) {
                { const pg8::Gemm g{(const bf16_t*)HXM8, O, WG_T, WBR_T, 512, 512, 1024, nullptr, nullptr, 0x7A7A7A7A, 0x7F7F7F7F, 1024}; const SchedMerge S{1024, 1056, G, vc};
                  EpiMerge E{}; E.outp = MB;
                  pg8::gemm_phase<EpiMerge, SchedMerge, false, true, false, true>(lds, g, S, E, tid); }
                { const pg8::Gemm g{MB, MB, WOUT_T, WOUT_T, 1024, 1024, 1024, nullptr, nullptr, 0, 0x7F7F7F7F, 0}; const Sched2D S{128, 4, 224, vc >= 32 ? vc - 32 : (1 << 20), 0, 0, 16, 0}; const EpiPlain E{O, 1024, NROW};
                  pg8::gemm_phase<EpiPlain, Sched2D>(lds, g, S, E, tid); }
            } else {
            const pg8::Gemm g{MB, MB, WOUT_T + (size_t)l * 1024 * 1024, WOUT_T, 1024, 1024, 1024, nullptr, PARTB, 0, 0x7F7F7F7F, 0}; const Sched2D S{128, 4, G, vc, 0, 0, 16, 0}; const EpiPlain E{O, 1024, NROW};
            SPLIT_GEMM(EpiPlain, Sched2D, false, g, S, E, 16);
            }
            SEAM();
        }
        if (RUN(9, P + 8)) for (int rep_ = 0; rep_ < (l == 0 ? DUPN(9) : 1); ++rep_) { PHASE_PTRS;
            LAS float* RT = (LAS float*)lds; LAS int* wcnt = (LAS int*)(lds + 32768);
            if (l == 1) { for (int i = tid; i < 8192; i += 512) RT[i] = A->in[I_RT][i]; if (tid < 8) wcnt[tid] = 0; __syncthreads(); }
            unsigned* tctr = (unsigned*)(ws + WS_CTL) + CW_TAIL;
            if (l == 0 && vc < 16) {
                const pg8::Gemm g{MB, MB, WOUT_T, WOUT_T, 1024, 1024, 1024, nullptr, nullptr, 0, 0x7F7F7F7F, 0}; const Sched2D S{4, 4, G, vc, 0, 0, 16, 0, 128}; const EpiPlain E{O, 1024, NROW};
                pg8::gemm_phase<EpiPlain, Sched2D>(lds, g, S, E, tid);
                tail_signal(tctr, tid);
            }
            const Row16 Tgpost = row_load_f32(A->in[I_GPOSTMIX] + l * DM, lane), Tgpre = row_load_f32(A->in[I_GPREFFN] + l * DM, lane); Row16 Tgate{}, Tsc{}, Tsh{}; int cbi = -1;
#pragma unroll 1
            for (int pass = 0; pass < (l == 0 ? 2 : 1); ++pass) {
            int rbase, nit;
            if (l == 1) { rbase = bx * 128 + wave * 16; nit = 16; }
            else if (pass == 0) { const int nidx = (vc - 16) * 8 + wave; rbase = nidx * 17 + (nidx < 128 ? nidx : 128); nit = (vc < 16) ? 0 : 17 + (nidx < 128 ? 1 : 0); }
            else { tail_wait(tctr, 16u, (unsigned*)(ws + WS_CTL) + CW_BAR, tid); rbase = NLAT + gw; nit = (gw < NROW - NLAT) ? 1 : 0; }
            Row16 xn{}, fn{};
            if (nit > 0 && rbase < nrow) { const float* xq = (l == 0) ? (rbase < NLAT ? A->in[I_X] + (size_t)rbase * DM : A->in[I_CTX] + (size_t)(rbase - NLAT) * DM) : out + (size_t)rbase * DM;
                xn = (l == 1) ? row_load_bf16((const bf16_t*)xq, lane) : row_load_f32(xq, lane); fn = row_load_bf16(O + (size_t)rbase * DM, lane); }
            for (int it = 0; it < nit; ++it) { const int r = rbase + it; if (r >= nrow) break;
                const int bi = r < NLAT ? (r >> 13) : 4; const float* mb = (MOD + (size_t)l * 5 * 6144) + bi * 6144;
                if (bi != cbi) { Tgate = row_load_f32(mb + 2 * 1024, lane); Tsc = row_load_f32(mb + 4 * 1024, lane); Tsh = row_load_f32(mb + 3 * 1024, lane); cbi = bi; }
                float* xo = r < NLAT ? out + (size_t)r * DM : HCTX + (size_t)(r - NLAT) * DM;
                const Row16 x = xn, f = fn;
                { const int rn = r + 1; if (it + 1 < nit && rn < nrow) { const float* xq = (l == 0) ? (rn < NLAT ? A->in[I_X] + (size_t)rn * DM : A->in[I_CTX] + (size_t)(rn - NLAT) * DM) : out + (size_t)rn * DM;
                    xn = (l == 1) ? row_load_bf16((const bf16_t*)xq, lane) : row_load_f32(xq, lane); fn = row_load_bf16(O + (size_t)rn * DM, lane); } }
                const Row16 x1 = row_resid_t(x, f, Tgpost, Tgate); if (r < NLAT) row_store_bf16((bf16_t*)xo, x1, lane); else row_store_f32(xo, x1, lane);
                const Row16 h2 = row_norm_mod_t(x1, Tgpre, Tsc, Tsh); if (l == 0 || FP8_FFN_UP) row_store_bf16(HX + (size_t)r * DM, h2, lane);
                if (l == 1) { unsigned* h8 = (unsigned*)(HX8 + (size_t)r * DM) + lane;
#pragma unroll
                  for (int j = 0; j < 4; ++j) h8[64 * j] = pk4_fp8(h2.v[j][0], h2.v[j][1], h2.v[j][2], h2.v[j][3]); }
                if (l == 1) {
                    float lg[8] = {0.f, 0.f, 0.f, 0.f, 0.f, 0.f, 0.f, 0.f};
#pragma unroll
                    for (int j = 0; j < 4; ++j)
#pragma unroll
                        for (int q = 0; q < 4; ++q) { const int k = 256 * j + 4 * lane + q; const f32x4 w0 = *(const LAS f32x4*)(RT + k * 8), w1 = *(const LAS f32x4*)(RT + k * 8 + 4); const float hv = h2.v[j][q];
                            lg[0] += hv * w0[0]; lg[1] += hv * w0[1]; lg[2] += hv * w0[2]; lg[3] += hv * w0[3]; lg[4] += hv * w1[0]; lg[5] += hv * w1[1]; lg[6] += hv * w1[2]; lg[7] += hv * w1[3]; }
#pragma unroll
                    for (int e = 0; e < 8; ++e) lg[e] = wave_sum(lg[e]);
                    int i0 = 0; float v0 = lg[0];
#pragma unroll
                    for (int e = 1; e < 8; ++e) if (lg[e] > v0) { v0 = lg[e]; i0 = e; }
                    int i1 = -1; float v1 = -INFINITY;
#pragma unroll
                    for (int e = 0; e < 8; ++e) if (e != i0 && lg[e] > v1) { v1 = lg[e]; i1 = e; }
                    const float w0 = 1.0f / (1.0f + __expf(v1 - v0)), w1 = 1.0f - w0;
                    if (lane == 0) { TOPI[2 * r] = i0; TOPI[2 * r + 1] = i1; TOPW[2 * r] = w0; TOPW[2 * r + 1] = w1; __hip_atomic_fetch_add(wcnt + i0, 1, __ATOMIC_RELAXED, __HIP_MEMORY_SCOPE_WORKGROUP); __hip_atomic_fetch_add(wcnt + i1, 1, __ATOMIC_RELAXED, __HIP_MEMORY_SCOPE_WORKGROUP); }
                }
            }
            }
            if (l == 1) { __syncthreads(); if (tid < 8) WCNT[bx * 8 + tid] = wcnt[tid]; }
            SEAM();
        }
        if (l == 0) {
            if (RUN(10, P + 9)) for (int rep_ = 0; rep_ < DUPN(10); ++rep_) { PHASE_PTRS;
                const pg8::Gemm g8{(const bf16_t*)HX8, (const bf16_t*)HX8, W13_T, W13_T, 512, 512, 1024, nullptr, nullptr, 0x7A7A7A7A, 0x7F7F7F7F, 0}; const Sched2D S8{132, 22, G, vc, 0, 0, 8, 2};
                const pg8::Gemm g{HX, HX, W13_T, W13_T, 1024, 1024, 1024, nullptr, nullptr, 0, 0, 0}; const Sched2D S{132, 22, G, vc, 0, 0, 16, 2};
                const EpiSwiglu8 E8{(unsigned char*)HB, FFN}; const EpiSwiglu E{HB, FFN};
                if constexpr (FP8_FFN_UP) { if constexpr (FP8_FFN_DN) pg8::gemm_phase<EpiSwiglu8, Sched2D, false, false, true>(lds, g8, S8, E8, tid); else pg8::gemm_phase<EpiSwiglu, Sched2D, false, false, true>(lds, g8, S8, E, tid); }
                else { if constexpr (FP8_FFN_DN) pg8::gemm_phase<EpiSwiglu8, Sched2D>(lds, g, S, E8, tid); else pg8::gemm_phase<EpiSwiglu, Sched2D>(lds, g, S, E, tid); }
                SEAM();
            }
            if (RUN(11, P + 10)) for (int rep_ = 0; rep_ < DUPN(11); ++rep_) { PHASE_PTRS;
                const EpiPlain E{HX, 1024, NROW};
                if constexpr (FP8_FFN_DN) { const pg8::Gemm g{HB, HB, W2_T, W2_T, FFN / 2, FFN / 2, FFN, nullptr, nullptr, 0x79797979, 0x7C7C7C7C, 0}; const Sched2D S{128, 4, G, vc, 0, 0, 22, 0}; pg8::gemm_phase<EpiPlain, Sched2D, false, false, true>(lds, g, S, E, tid); }
                else { const pg8::Gemm g{HB, HB, W2_T, W2_T, FFN, FFN, FFN, nullptr, nullptr, 0, 0, 0}; const Sched2D S{128, 4, G, vc, 0, 0, 44, 0}; pg8::gemm_phase<EpiPlain, Sched2D>(lds, g, S, E, tid); }
                SEAM();
            }
            if (RUN(12, P + 11)) for (int rep_ = 0; rep_ < DUPN(12); ++rep_) { PHASE_PTRS;
                const float* mod1 = MOD + (size_t)5 * 6144;
                unsigned* tctr = (unsigned*)(ws + WS_CTL) + CW_TAIL + 16;
                if (vc < 16) {
                    const EpiPlain E{HX, 1024, NROW};
                    if constexpr (FP8_FFN_DN) { const pg8::Gemm g{HB, HB, W2_T, W2_T, FFN / 2, FFN / 2, FFN, nullptr, nullptr, 0x79797979, 0x7C7C7C7C, 0}; const Sched2D S{4, 4, G, vc, 0, 0, 22, 0, 128}; pg8::gemm_phase<EpiPlain, Sched2D, false, false, true>(lds, g, S, E, tid); }
                    else { const pg8::Gemm g{HB, HB, W2_T, W2_T, FFN, FFN, FFN, nullptr, nullptr, 0, 0, 0}; const Sched2D S{4, 4, G, vc, 0, 0, 44, 0, 128}; pg8::gemm_phase<EpiPlain, Sched2D>(lds, g, S, E, tid); }
                    tail_signal(tctr, tid);
                }
                { const Row16 Tgf = row_load_f32(A->in[I_GPOSTFFN], lane), Tgm = row_load_f32(A->in[I_GPREMIX] + DM, lane); Row16 Tgate{}, Tsc{}, Tsh{}; int cbi = -1;
#pragma unroll 1
                  for (int pass = 0; pass < 2; ++pass) {
                  int r0, r1;
                  if (pass == 0) { const int nidx = (vc - 16) * 8 + wave; r0 = nidx * 17 + (nidx < 128 ? nidx : 128); r1 = (vc < 16) ? r0 : r0 + 17 + (nidx < 128 ? 1 : 0); }
                  else { tail_wait(tctr, 16u, (unsigned*)(ws + WS_CTL) + CW_BAR, tid); r0 = NLAT + gw; r1 = (gw < NROW - NLAT) ? r0 + 1 : r0; }
                  Row16 xn{}, fn{}; if (r0 < r1) { xn = (r0 < NLAT) ? row_load_bf16((const bf16_t*)(out + (size_t)r0 * DM), lane) : row_load_f32(HCTX + (size_t)(r0 - NLAT) * DM, lane); fn = row_load_bf16(HX + (size_t)r0 * DM, lane); }
                  for (int r = r0; r < r1; ++r) { const int bi = r < NLAT ? (r >> 13) : 4; float* xo = r < NLAT ? out + (size_t)r * DM : HCTX + (size_t)(r - NLAT) * DM;
                    if (bi != cbi) { Tgate = row_load_f32((MOD + (size_t)l * 5 * 6144) + bi * 6144 + 5 * 1024, lane); Tsc = row_load_f32(mod1 + bi * 6144 + 1024, lane); Tsh = row_load_f32(mod1 + bi * 6144, lane); cbi = bi; }
                    const Row16 x = xn, f = fn; const int rn = r + 1;
                    if (rn < r1) { xn = (rn < NLAT) ? row_load_bf16((const bf16_t*)(out + (size_t)rn * DM), lane) : row_load_f32(HCTX + (size_t)(rn - NLAT) * DM, lane); fn = row_load_bf16(HX + (size_t)rn * DM, lane); }
                    const Row16 x2 = row_resid_t(x, f, Tgf, Tgate); if (r < NLAT) row_store_bf16((bf16_t*)xo, x2, lane); else row_store_f32(xo, x2, lane);
                    const Row16 y = row_norm_mod_t(x2, Tgm, Tsc, Tsh); row_store_bf16(HX + (size_t)r * DM, y, lane);
                    { unsigned* h8 = (unsigned*)(HXM8 + (size_t)r * DM) + lane;
#pragma unroll
                      for (int j = 0; j < 4; ++j) h8[64 * j] = pk4_fp8(y.v[j][0], y.v[j][1], y.v[j][2], y.v[j][3]); } } } }
                SEAM();
            }
        } else {
            if (RUN(13, P + 9)) for (int rep_ = 0; rep_ < DUPN(13); ++rep_) { PHASE_PTRS;
                LAS int* gl = (LAS int*)(lds + 512); LAS int* off = (LAS int*)(lds + 2048); LAS int* wv = (LAS int*)(lds + 3072); LAS int* wc = (LAS int*)(lds + 8192); LAS int* PF = (LAS int*)(lds + 16384);
                for (int i = tid; i < 2048; i += 512) wc[i] = WCNT[i];
                __syncthreads();
                { const int e = wave;
                  const int v0 = wc[(4 * lane) * 8 + e], v1 = wc[(4 * lane + 1) * 8 + e], v2 = wc[(4 * lane + 2) * 8 + e], v3 = wc[(4 * lane + 3) * 8 + e];
                  const int tot = v0 + v1 + v2 + v3; int inc = tot;
#pragma unroll
                  for (int o = 1; o < 64; o <<= 1) { const int t = __shfl_up(inc, o); if (lane >= o) inc += t; }
                  const int ex = inc - tot;
                  PF[(4 * lane + 1) * 8 + e] = ex + v0; PF[(4 * lane + 2) * 8 + e] = ex + v0 + v1; PF[(4 * lane + 3) * 8 + e] = ex + v0 + v1 + v2; PF[(4 * lane + 4) * 8 + e] = ex + tot;
                  if (lane == 0) PF[e] = 0; }
                __syncthreads();
                if (tid == 0) { int ng = 0, st = 0;
                    while (st < 256) { int lo = st + 1, hi = 256;
                        while (lo < hi) { const int mid = (lo + hi + 1) >> 1; int tiles = 0;
#pragma unroll
                            for (int e = 0; e < 8; ++e) tiles += (PF[mid * 8 + e] - PF[st * 8 + e] + 255) >> 8;
                            if (tiles <= 64) lo = mid; else hi = mid - 1; }
                        gl[1 + ng] = st; int b = 0;
#pragma unroll
                        for (int e = 0; e < 8; ++e) { gl[16 + ng * 16 + e] = b; b += (PF[lo * 8 + e] - PF[st * 8 + e] + 255) & ~255; }
                        gl[16 + ng * 16 + 8] = b; ++ng; st = lo; }
                    gl[1 + ng] = 256; gl[0] = ng; }
                __syncthreads();
                int gq = 0; while (gl[2 + gq] <= bx) ++gq;
                const int gs = gl[1 + gq], ge = gl[2 + gq];
                if (tid < 8) off[tid] = gl[16 + gq * 16 + tid] + PF[bx * 8 + tid] - PF[gs * 8 + tid];
                int pe = -1, rk = 0;
                if (tid < 256) pe = TOPI[2 * (bx * 128) + tid];
#pragma unroll
                for (int k = 0; k < 8; ++k) { const unsigned long long m = __ballot(pe == k); if (pe == k) rk = __popcll(m & ((1ull << lane) - 1ull)); if (lane == 0 && wave < 4) wv[wave * 8 + k] = __popcll(m); }
                __syncthreads();
                if (tid < 256) { int o = off[pe]; for (int w = 0; w < wave; ++w) o += wv[w * 8 + pe]; const int s_ = o + rk; SLOT[2 * (bx * 128) + tid] = s_; ROWTOK[gq * 16384 + s_] = bx * 128 + (tid >> 1); }
                if (bx == gs) { for (int e = 0; e < 8; ++e) { const int n = PF[ge * 8 + e] - PF[gs * 8 + e];
                        for (int s_ = gl[16 + gq * 16 + e] + n + tid; s_ < gl[16 + gq * 16 + e + 1]; s_ += 512) ROWTOK[gq * 16384 + s_] = bx * 128; } }
                __syncthreads();
                for (int i = tid; i < 16 + 16 * 16; i += 512) { ((LAS int*)(lds + GRPL_OFF))[i] = gl[i]; if (bx == 0) GRP[i] = gl[i]; }
                SEAM();
            }
#pragma unroll 1
            for (int q = 0; q <= 9; ++q) {
                if (RUN(14, P + 10 + 2 * q)) for (int rep_ = 0; rep_ < DUPN(14); ++rep_) { PHASE_PTRS;
                    moe_load(mbase, (const LAS int*)(lds + GRPL_OFF), q, tid); const int ng = mbase[16];
                    if (q <= ng) {
                        if (q > 0) { const int t0 = mbase[19] * 128, t1 = mbase[17] * 128;
                            const Row16 Tgf = row_load_f32(A->in[I_GPOSTFFN] + DM, lane); Row16 Tgate{}; int cbi = -1;
                            for (int t = t0 + gw; t < t1; t += NGW) { const int s0 = SLOT[2 * t], s1 = SLOT[2 * t + 1]; const float w0 = TOPW[2 * t], w1 = TOPW[2 * t + 1];
                                const int bi = t >> 13; if (bi != cbi) { Tgate = row_load_f32((MOD + (size_t)5 * 6144) + bi * 6144 + 5 * 1024, lane); cbi = bi; }
                                const Row16 a = row_load_bf16(MY + (size_t)s0 * DM, lane), b = row_load_bf16(MY + (size_t)s1 * DM, lane); Row16 f;
#pragma unroll
                                for (int j = 0; j < 4; ++j) f.v[j] = a.v[j] * w0 + b.v[j] * w1;
                                const Row16 x = row_load_bf16((const bf16_t*)(out + (size_t)t * DM), lane);
                                const Row16 x2 = row_resid_t(x, f, Tgf, Tgate); row_store_f32(out + (size_t)t * DM, x2, lane); } }
                        if (q < ng) {
                            const pg8::Gemm g{(const bf16_t*)HX8, (const bf16_t*)HX8, MW13_T, MW13_T, 512, 512, 1024, ROWTOK + q * 16384, nullptr, 0x7A7A7A7A, 0x7F7F7F7F, 0}; const SchedMoe S{mbase, 28, G, vc, 7168 * 512, 8}; const EpiSwiglu8 E{(unsigned char*)MH, EXD};
                            pg8::gemm_phase<EpiSwiglu8, SchedMoe, true, false, true>(lds, g, S, E, tid);
                            SEAM(); }
                    }
                }
                if (RUN(15, P + 11 + 2 * q)) for (int rep_ = 0; rep_ < DUPN(15); ++rep_) { PHASE_PTRS;
                    moe_load(mbase, (const LAS int*)(lds + GRPL_OFF), q, tid); const int ng = mbase[16];
                    if (q < ng) {
                        const pg8::Gemm g{MH, MH, MW2_T, MW2_T, EXD / 2, EXD / 2, EXD, nullptr, nullptr, 0x79797979, 0x7C7C7C7C, 0}; const SchedMoe S{mbase, 4, G, vc, 1024 * (EXD / 2), 28}; const EpiPlain E{MY, 1024, 16384};
                        pg8::gemm_phase<EpiPlain, SchedMoe, false, false, true>(lds, g, S, E, tid);
                        SEAM(); }
                }
            }
        }
    }
#undef RUN
#undef SEAM
}

extern "C" void kernel_launch(void* const* d_in, const int* in_sizes, int n_in, void* d_out, int out_size, void* d_ws, size_t ws_size, hipStream_t stream) {
    static int grid = 0;
    if (grid == 0) {
        if (n_in != N_IN || out_size != NLAT * DM || ws_size < WS_END) { fprintf(stderr, "kernel_launch: unexpected problem (n_in %d, out %d, ws %zu); nothing launched\n", n_in, out_size, ws_size); grid = -1; return; }
        int dev = 0, cus = 0, per_cu = 0;
        if (hipGetDevice(&dev) != hipSuccess || hipDeviceGetAttribute(&cus, hipDeviceAttributeMultiprocessorCount, dev) != hipSuccess) { grid = -1; return; }
        if (hipFuncSetAttribute((const void*)fwd, hipFuncAttributeMaxDynamicSharedMemorySize, LDS_BYTES) != hipSuccess) { fprintf(stderr, "kernel_launch: hipFuncSetAttribute failed\n"); grid = -1; return; }
        if (hipOccupancyMaxActiveBlocksPerMultiprocessor(&per_cu, (const void*)fwd, 512, LDS_BYTES) != hipSuccess || per_cu < 1) fprintf(stderr, "kernel_launch: occupancy query reports %d\n", per_cu);
        (void)hipGetLastError();
        if (cus < 256) { fprintf(stderr, "kernel_launch: built for a 256-CU device\n"); grid = -1; return; }
        grid = 256;
    }
    if (grid < 0) return;
    (void)hipMemsetAsync((char*)d_ws + WS_CTL, 0, CTL_ZERO_BYTES, stream);
    Args a{};
    for (int i = 0; i < N_IN; ++i) a.in[i] = (const float*)d_in[i];
    a.out = (float*)d_out; a.ws = (unsigned char*)d_ws;
#if MK_MULTI
    for (int ph = 0; ph < N_PHASES; ++ph) { a.ph_lo = ph; a.ph_hi = ph + 1; hipLaunchKernelGGL(fwd, dim3(grid), dim3(512), LDS_BYTES, stream, a); }
#else
    a.ph_lo = 0; a.ph_hi = N_PHASES;
    hipLaunchKernelGGL(fwd, dim3(grid), dim3(512), LDS_BYTES, stream, a);
#endif
}
```
